# Optimizing an MI355X kernel written in HIP

```python
import math
import jax
import jax.numpy as jnp
from jax import lax
import numpy as np

D_MODEL = 1024
BATCH = 32
SEQ = 2048
DEPTH = 2

GRID_W = 64
CTX_LEN = 256
F32 = jnp.float32
NORM_EPS = 1e-6
HG_HEADS = 4
HG_HEAD_DIM = 128
HG_WIDTH = HG_HEADS * HG_HEAD_DIM
HG_CHUNK = 32
HG_EXP_CLIP = 30.0
AT_HEADS = 8
AT_KV_HEADS = 2
AT_HEAD_DIM = 64
AT_GROUP = AT_HEADS // AT_KV_HEADS
AT_Q_BLOCK = 128
ROPE_THETA = 10000.0
HY_WIDTH = 512
HY_EMB_DIM = 33
HY_BANDS = (HY_EMB_DIM - 1) // 2
HY_FILTER_WIDTH = 64
HY_INNER = 2
HY_FAST_DECAY = 0.3
HY_SLOW_DECAY = 1.5
HY_TARGET = 1e-2
D_FF = 2816
SPLIT_SIZES = (HG_WIDTH, HG_WIDTH, HG_WIDTH, HG_WIDTH, HG_WIDTH,
               AT_HEADS * AT_HEAD_DIM, AT_KV_HEADS * AT_HEAD_DIM, AT_KV_HEADS * AT_HEAD_DIM,
               3 * HY_WIDTH, 3 * D_MODEL)
D_IN = sum(SPLIT_SIZES)
SPLIT_POINTS = tuple(sum(SPLIT_SIZES[:i + 1]) for i in range(len(SPLIT_SIZES) - 1))

kernel_name = "hybrid_dit_hgrn2_gqa_hyena_ctxprefix"


def rmsnorm(x, g):
    xf = x.astype(F32)
    y = xf * lax.rsqrt(jnp.mean(xf * xf, axis=-1, keepdims=True) + NORM_EPS)
    return (y * g.astype(F32)).astype(x.dtype)


def modulate(x, g, shift, scale):
    return rmsnorm(x, g) * (1 + scale) + shift


def dwconv3(x, w, b):
    xp = jnp.pad(x, ((0, 0), (1, 1), (0, 0)))
    return xp[:, :-2] * w[0] + xp[:, 1:-1] * w[1] + xp[:, 2:] * w[2] + b


def rev(a):
    return a[:, ::-1]


def hg_heads(z):
    return z.astype(F32).reshape(z.shape[:2] + (HG_HEADS, HG_HEAD_DIM))


def hgrn_decay(zf, lb):
    zf = hg_heads(zf)
    lb = lb.reshape(HG_HEADS, HG_HEAD_DIM)
    log_f = jax.nn.log_sigmoid(zf) + jnp.log1p(lb * jnp.exp(jnp.minimum(-zf, HG_EXP_CLIP)))
    k = (1.0 - lb) * jax.nn.sigmoid(-zf)
    return log_f, k


def hgrn_chunk_scan(q, log_f, k, v, s0):
    B, L, H, _ = q.shape
    n = L // HG_CHUNK
    mask = jnp.tril(jnp.ones((HG_CHUNK, HG_CHUNK), dtype=bool))[:, :, None]

    def to_chunks(a):
        return a.reshape(B, n, HG_CHUNK, H, a.shape[-1]).transpose(1, 0, 3, 2, 4)

    def step(S, inp):
        qc, lfc, kc, vc = inp
        G = jnp.cumsum(lfc, axis=2)
        diff = G[:, :, :, None, :] - G[:, :, None, :, :]
        decay = jnp.where(mask, jnp.exp(jnp.where(mask, diff, 0.0)), 0.0)
        A = jnp.einsum('bhtk,bhtsk,bhsk->bhts', qc, decay, kc)
        o = jnp.einsum('bhts,bhsv->bhtv', A, vc) + jnp.einsum('bhtk,bhkv->bhtv', qc * jnp.exp(G), S)
        G_last = G[:, :, -1:, :]
        S = jnp.exp(G_last[:, :, 0, :])[..., None] * S + jnp.einsum('bhsk,bhsv->bhkv', kc * jnp.exp(G_last - G), vc)
        return S, o

    S, o = lax.scan(step, s0, (to_chunks(q), to_chunks(log_f), to_chunks(k), to_chunks(v)))
    o = o.transpose(1, 0, 3, 2, 4).reshape(B, L, H, v.shape[-1])
    return o, S


def hgrn_final_state(log_f, k, v):
    rest = lax.cumsum(log_f, axis=1, reverse=True) - log_f
    return jnp.einsum('blhk,blhv->bhkv', k * jnp.exp(rest), v)


def hgrn_out(o, zg, g_norm, dtype):
    B, L = o.shape[:2]
    return (rmsnorm(o, g_norm).reshape(B, L, HG_WIDTH) * jax.nn.silu(zg.astype(F32))).astype(dtype)


def axial_rope(L):
    rows = L // GRID_W
    row = jnp.repeat(jnp.arange(rows), GRID_W).astype(F32)
    col = jnp.tile(jnp.arange(GRID_W), rows).astype(F32)
    n_freq = AT_HEAD_DIM // 4
    inv = ROPE_THETA ** (-jnp.arange(n_freq, dtype=F32) / n_freq)
    ang = jnp.concatenate([row[:, None] * inv, col[:, None] * inv], axis=-1)
    return jnp.cos(ang), jnp.sin(ang)


def apply_rope(x, cos, sin):
    xf = x.astype(F32).reshape(x.shape[:-1] + (AT_HEAD_DIM // 2, 2))
    x1, x2 = xf[..., 0], xf[..., 1]
    c = cos[None, :, None, :]
    s = sin[None, :, None, :]
    out = jnp.stack([x1 * c - x2 * s, x1 * s + x2 * c], axis=-1)
    return out.reshape(x.shape).astype(x.dtype)


def attn_heads(zq, zk, zv, q_g, k_g):
    B, L = zq.shape[:2]
    q = rmsnorm(zq.reshape(B, L, AT_HEADS, AT_HEAD_DIM), q_g)
    k = rmsnorm(zk.reshape(B, L, AT_KV_HEADS, AT_HEAD_DIM), k_g)
    v = zv.reshape(B, L, AT_KV_HEADS, AT_HEAD_DIM)
    return q, k, v


def gqa_softmax(q, k, v):
    s = jnp.einsum('bqhgd,bkhd->bhgqk', q, k).astype(F32) * (AT_HEAD_DIM ** -0.5)
    p = jax.nn.softmax(s, axis=-1).astype(v.dtype)
    return jnp.einsum('bhgqk,bkhd->bqhgd', p, v)


def attend_latent(q, k_all, v_all):
    B, L = q.shape[:2]
    nb = L // AT_Q_BLOCK
    qb = q.reshape(B, nb, AT_Q_BLOCK, AT_KV_HEADS, AT_GROUP, AT_HEAD_DIM).transpose(1, 0, 2, 3, 4, 5)
    out = lax.map(lambda qblk: gqa_softmax(qblk, k_all, v_all), qb)
    return out.transpose(1, 0, 2, 3, 4, 5).reshape(B, L, AT_HEADS * AT_HEAD_DIM)


def hyena_filters(L, w1, b1, wi, bi, freq, w_last):
    t = jnp.linspace(0.0, 1.0, L, dtype=F32)[:, None]
    w = 2.0 * math.pi * jnp.arange(L, dtype=F32)[:, None] / L
    f = jnp.linspace(1e-4, HY_BANDS - 1, HY_BANDS, dtype=F32)[None, :]
    z = jnp.concatenate([t, jnp.cos(f * w), -jnp.sin(f * w)], axis=-1)
    fr = freq.astype(F32)
    h = jnp.sin(fr * (z @ w1.astype(F32) + b1.astype(F32)))
    for j in range(HY_INNER):
        h = jnp.sin(fr * (h @ wi[j].astype(F32) + bi[j].astype(F32)))
    h = h @ w_last.astype(F32)
    max_decay = math.log(HY_TARGET) / HY_FAST_DECAY
    min_decay = math.log(HY_TARGET) / HY_SLOW_DECAY
    deltas = jnp.abs(jnp.linspace(min_decay, max_decay, HY_WIDTH, dtype=F32))
    decay = jnp.exp(-t * deltas)
    return h[:, :HY_WIDTH] * decay, h[:, HY_WIDTH:] * decay


def bidir_fftconv(u, h_f, h_b):
    L = u.shape[1]
    kern = jnp.concatenate([(h_f[0] + h_b[0])[None], h_f[1:], jnp.zeros_like(h_f[:1]), h_b[:0:-1]], axis=0)
    U = jnp.fft.rfft(u, n=2 * L, axis=1)
    K = jnp.fft.rfft(kern, axis=0)
    return jnp.fft.irfft(U * K[None], n=2 * L, axis=1)[:, :L]


def hyena(z, conv_w, conv_b, filt, d_bias):
    zc = dwconv3(z, conv_w, conv_b).astype(F32)
    x0, x1, v = jnp.split(zc, 3, axis=-1)
    h_f, h_b = filt
    u = v * x1
    y = bidir_fftconv(u, h_f, h_b) + u * d_bias.astype(F32)
    return (y * x0).astype(z.dtype)


def mixer(hx, hc, p, lb_f, lb_b, need_ctx):
    B, L, _ = hx.shape
    Lc = hc.shape[1]
    dt = hx.dtype
    px = jnp.split(hx @ p['w_in'], SPLIT_POINTS, axis=-1)
    pc = jnp.split(hc @ p['w_in'], SPLIT_POINTS, axis=-1)

    qx, vx, qc, vc = hg_heads(px[0]), hg_heads(px[3]), hg_heads(pc[0]), hg_heads(pc[3])
    lfx_f, kx_f = hgrn_decay(px[1], lb_f)
    lfx_b, kx_b = hgrn_decay(px[2], lb_b)
    lfc_f, kc_f = hgrn_decay(pc[1], lb_f)
    lfc_b, kc_b = hgrn_decay(pc[2], lb_b)
    if need_ctx:
        s0 = jnp.zeros((B, HG_HEADS, HG_HEAD_DIM, HG_HEAD_DIM), F32)
        oc_f, sf = hgrn_chunk_scan(qc, lfc_f, kc_f, vc, s0)
        oc_b, sb = hgrn_chunk_scan(rev(qc), rev(lfc_b), rev(kc_b), rev(vc), s0)
        a_c = hgrn_out(oc_f + rev(oc_b), pc[4], p['hg_norm'], dt)
    else:
        sf = hgrn_final_state(lfc_f, kc_f, vc)
        sb = hgrn_final_state(rev(lfc_b), rev(kc_b), rev(vc))
    ox_f, _ = hgrn_chunk_scan(qx, lfx_f, kx_f, vx, sf)
    ox_b, _ = hgrn_chunk_scan(rev(qx), rev(lfx_b), rev(kx_b), rev(vx), sb)
    a_x = hgrn_out(ox_f + rev(ox_b), px[4], p['hg_norm'], dt)

    cos, sin = axial_rope(L)
    aq_x, ak_x, av_x = attn_heads(px[5], px[6], px[7], p['q_norm'], p['k_norm'])
    aq_c, ak_c, av_c = attn_heads(pc[5], pc[6], pc[7], p['q_norm'], p['k_norm'])
    aq_x = apply_rope(aq_x, cos, sin)
    ak_x = apply_rope(ak_x, cos, sin)
    k_all = jnp.concatenate([ak_c, ak_x], axis=1)
    v_all = jnp.concatenate([av_c, av_x], axis=1)
    b_x = attend_latent(aq_x, k_all, v_all)

    filt_args = (p['hy_w1'], p['hy_b1'], p['hy_wi'], p['hy_bi'], p['hy_freq'], p['hy_w_last'])
    c_x = hyena(px[8], p['hy_conv_w'], p['hy_conv_b'], hyena_filters(L, *filt_args), p['hy_bias'])

    def merge(parts, a, b, c):
        g_a, g_b, g_c = jnp.split(parts[9], 3, axis=-1)
        m = (jax.nn.sigmoid(g_a) * (a @ p['w_oa']) + jax.nn.sigmoid(g_b) * (b @ p['w_ob'])
             + jax.nn.sigmoid(g_c) * (c @ p['w_oc']))
        return m @ p['w_out']

    yx = merge(px, a_x, b_x, c_x)
    if need_ctx:
        b_c = gqa_softmax(aq_c.reshape(B, Lc, AT_KV_HEADS, AT_GROUP, AT_HEAD_DIM), ak_c, av_c).reshape(B, Lc, AT_HEADS * AT_HEAD_DIM)
        c_c = hyena(pc[8], p['hy_conv_w'], p['hy_conv_b'], hyena_filters(Lc, *filt_args), p['hy_bias'])
        return yx, merge(pc, a_c, b_c, c_c)
    return yx, None


def conv_ffn(h, w_up, cw, cb, w_down):
    u = dwconv3(h @ w_up, cw, cb)
    a, b = jnp.split(u, 2, axis=-1)
    return (jax.nn.silu(a) * b) @ w_down


def setup_inputs(seed: int = 0) -> dict:
    key = jax.random.key(seed)
    D = D_MODEL
    specs = [
        ('x', (BATCH, SEQ, D), 1.0, 0.0),
        ('c', (BATCH, D), 1.0, 0.0),
        ('ctx', (BATCH, CTX_LEN, D), 1.0, 0.0),
        ('c_ctx', (D,), 1.0, 0.0),
        ('w_ada', (DEPTH, D, 6 * D), 0.5 * D ** -0.5, 0.0),
        ('b_ada', (DEPTH, 6 * D), 0.02, 0.0),
        ('g_pre_mix', (DEPTH, D), 0.02, 1.0),
        ('g_post_mix', (DEPTH, D), 0.02, 1.0),
        ('g_pre_ffn', (DEPTH, D), 0.02, 1.0),
        ('g_post_ffn', (DEPTH, D), 0.02, 1.0),
        ('w_in', (DEPTH, D, D_IN), D ** -0.5, 0.0),
        ('hg_lower_bounds', (DEPTH, 2, HG_WIDTH), 0.1, 0.0),
        ('hg_norm', (DEPTH, HG_HEAD_DIM), 0.02, 1.0),
        ('q_norm', (DEPTH, AT_HEAD_DIM), 0.02, 1.0),
        ('k_norm', (DEPTH, AT_HEAD_DIM), 0.02, 1.0),
        ('hy_conv_w', (DEPTH, 3, 3 * HY_WIDTH), 0.5, 0.0),
        ('hy_conv_b', (DEPTH, 3 * HY_WIDTH), 0.02, 0.0),
        ('hy_w1', (DEPTH, HY_EMB_DIM, HY_FILTER_WIDTH), HY_EMB_DIM ** -0.5, 0.0),
        ('hy_b1', (DEPTH, HY_FILTER_WIDTH), 0.1, 0.0),
        ('hy_wi', (DEPTH, HY_INNER, HY_FILTER_WIDTH, HY_FILTER_WIDTH), HY_FILTER_WIDTH ** -0.5, 0.0),
        ('hy_bi', (DEPTH, HY_INNER, HY_FILTER_WIDTH), 0.1, 0.0),
        ('hy_freq', (DEPTH, HY_FILTER_WIDTH), 0.02, 1.0),
        ('hy_w_last', (DEPTH, HY_FILTER_WIDTH, 2 * HY_WIDTH), 0.05 * HY_FILTER_WIDTH ** -0.5, 0.0),
        ('hy_bias', (DEPTH, HY_WIDTH), 1.0, 0.0),
        ('w_oa', (DEPTH, HG_WIDTH, D), HG_WIDTH ** -0.5, 0.0),
        ('w_ob', (DEPTH, AT_HEADS * AT_HEAD_DIM, D), (AT_HEADS * AT_HEAD_DIM) ** -0.5, 0.0),
        ('w_oc', (DEPTH, HY_WIDTH, D), HY_WIDTH ** -0.5, 0.0),
        ('w_out', (DEPTH, D, D), D ** -0.5, 0.0),
        ('w_up', (DEPTH, D, 2 * D_FF), D ** -0.5, 0.0),
        ('ffn_conv_w', (DEPTH, 3, 2 * D_FF), 0.5, 0.0),
        ('ffn_conv_b', (DEPTH, 2 * D_FF), 0.02, 0.0),
        ('w_down', (DEPTH, D_FF, D), D_FF ** -0.5, 0.0),
    ]
    keys = jax.random.split(key, len(specs))
    return {name: off + scale * jax.random.normal(k, shape, jnp.float32)
            for (name, shape, scale, off), k in zip(specs, keys)}


def reference(x, c, ctx, c_ctx, w_ada, b_ada, g_pre_mix, g_post_mix, g_pre_ffn, g_post_ffn,
              w_in, hg_lower_bounds, hg_norm, q_norm, k_norm, hy_conv_w, hy_conv_b, hy_w1, hy_b1,
              hy_wi, hy_bi, hy_freq, hy_w_last, hy_bias, w_oa, w_ob, w_oc, w_out,
              w_up, ffn_conv_w, ffn_conv_b, w_down):
    lbp = jax.nn.softmax(hg_lower_bounds.astype(F32), axis=0)
    lower = jnp.cumsum(lbp, axis=0) - lbp[0]
    src_x = jax.nn.silu(c)
    src_c = jax.nn.silu(c_ctx)
    for l in range(DEPTH):
        need_ctx = l < DEPTH - 1
        mx = jnp.split((src_x @ w_ada[l] + b_ada[l])[:, None, :], 6, axis=-1)
        mc = jnp.split((src_c @ w_ada[l] + b_ada[l])[None, None, :], 6, axis=-1)
        p = {'w_in': w_in[l], 'hg_norm': hg_norm[l], 'q_norm': q_norm[l], 'k_norm': k_norm[l],
             'hy_conv_w': hy_conv_w[l], 'hy_conv_b': hy_conv_b[l], 'hy_w1': hy_w1[l], 'hy_b1': hy_b1[l],
             'hy_wi': hy_wi[l], 'hy_bi': hy_bi[l], 'hy_freq': hy_freq[l], 'hy_w_last': hy_w_last[l],
             'hy_bias': hy_bias[l], 'w_oa': w_oa[l], 'w_ob': w_ob[l], 'w_oc': w_oc[l], 'w_out': w_out[l]}
        hx = modulate(x, g_pre_mix[l], mx[0], mx[1])
        hc = modulate(ctx, g_pre_mix[l], mc[0], mc[1])
        yx, yc = mixer(hx, hc, p, lower[l, 0], lower[l, 1], need_ctx)
        x = x + mx[2] * rmsnorm(yx, g_post_mix[l])
        fx = conv_ffn(modulate(x, g_pre_ffn[l], mx[3], mx[4]), w_up[l], ffn_conv_w[l], ffn_conv_b[l], w_down[l])
        x = x + mx[5] * rmsnorm(fx, g_post_ffn[l])
        if need_ctx:
            ctx = ctx + mc[2] * rmsnorm(yc, g_post_mix[l])
            fc = conv_ffn(modulate(ctx, g_pre_ffn[l], mc[3], mc[4]), w_up[l], ffn_conv_w[l], ffn_conv_b[l], w_down[l])
            ctx = ctx + mc[5] * rmsnorm(fc, g_post_ffn[l])
    return x
```

```cpp
#include <hip/hip_runtime.h>
#include <hip/hip_cooperative_groups.h>
#include <cstdio>
#include <cstdint>
namespace cg = cooperative_groups;

#define DI __device__ __forceinline__
#define LAS __attribute__((address_space(3)))
typedef unsigned short bf16_t;
typedef short bf16x8 __attribute__((ext_vector_type(8)));
typedef short s16x4 __attribute__((ext_vector_type(4)));
typedef float f32x2 __attribute__((ext_vector_type(2)));
typedef float f32x4 __attribute__((ext_vector_type(4)));
typedef float f32x16 __attribute__((ext_vector_type(16)));
typedef unsigned u32x2 __attribute__((ext_vector_type(2)));
typedef unsigned u32x4 __attribute__((ext_vector_type(4)));
typedef __bf16 bf16x2_t __attribute__((ext_vector_type(2)));

constexpr int D = 1024, NB = 32, L = 2048, LC = 256, ML = NB * L, MC = NB * LC, M = ML + MC, LT = L + LC;
constexpr int DIN = 7936, DFF = 2816, NUP = 5632;
constexpr float EPS = 1e-6f;
constexpr int NTHREADS = 512;
constexpr int LDS_BYTES = 147456;
constexpr size_t SZ_WIN = (size_t)DIN * D * 2, SZ_WO1 = (size_t)D * 512 * 2, SZ_WOUT = (size_t)D * D * 2, SZ_WUP = (size_t)NUP * D * 2, SZ_WDN = (size_t)D * DFF * 2;
constexpr size_t OFF_WIN = 0, OFF_WO = OFF_WIN + SZ_WIN, OFF_WOUT = OFF_WO + 3 * SZ_WO1, OFF_WUP = OFF_WOUT + SZ_WOUT, OFF_WDN = OFF_WUP + SZ_WUP, SZ_WL = OFF_WDN + SZ_WDN;
constexpr size_t WS_W = 0;
constexpr size_t WS_MODS = WS_W + 2 * SZ_WL;
constexpr size_t WS_RL = WS_MODS + (size_t)2 * 33 * 6144 * 4;
constexpr size_t WS_RC = WS_RL + (size_t)2 * 512 * 4096 * 2;
constexpr size_t WS_ROPE = WS_RC + (size_t)512 * 512 * 4;
constexpr size_t WS_CTXR = WS_ROPE + (size_t)2048 * 32 * 2 * 4;
constexpr size_t WS_CH = WS_CTXR + (size_t)MC * D * 4;
constexpr size_t WS_HX = WS_CH + (size_t)MC * 512 * 2;
constexpr size_t P_R1 = WS_HX + (size_t)M * D * 2;
constexpr size_t P_RQ = P_R1 + (size_t)M * 2560 * 2;
constexpr size_t P_RK = P_RQ + (size_t)M * 512 * 2;
constexpr size_t P_RV = P_RK + (size_t)NB * 2 * LT * 64 * 2;
constexpr size_t P_RU = P_RV + (size_t)NB * 2 * LT * 64 * 2;
constexpr size_t P_RX = P_RU + (size_t)512 * 128 * 64 * 16;
constexpr size_t P_RY = P_RX + (size_t)ML * 512 * 2;
constexpr size_t P_RB = P_RY + (size_t)512 * 2048 * 32 * 2;
constexpr size_t WS_CTL = P_RB + (size_t)M * 512 * 2;
constexpr size_t CTL_BYTES = 16384;
constexpr size_t WS_END = WS_CTL + CTL_BYTES;
constexpr int LDS_ST_OFF = LDS_BYTES - 16;
constexpr size_t A_OF = P_RU, A_OB = P_RU + (size_t)M * 512 * 2;
constexpr size_t A_GBUF = P_R1, A_MBUF = P_R1 + (size_t)M * D * 2;
constexpr size_t A_ACT = P_R1, A_ZUP = P_R1 + (size_t)M * DFF * 2;
static_assert(A_OB + (size_t)M * 512 * 2 <= P_RB, "scan outputs overlay");
static_assert(A_MBUF + (size_t)M * D * 2 <= P_RQ, "merge overlay");
static_assert(A_ZUP + (size_t)(M / 256) * 4 * NUP * 2 <= WS_CTL && (A_ZUP % 256) == 0, "ffn overlay");
static_assert(WS_END <= ((size_t)1 << 30), "workspace over 1 GiB");
static_assert((WS_MODS % 256) == 0 && (WS_RL % 256) == 0 && (WS_HX % 256) == 0 && (P_R1 % 256) == 0 && (P_RU % 256) == 0, "alignment");

#ifndef PROBE_MASK
#define PROBE_MASK 0
#endif
struct Params { const float* in[32]; float* out; unsigned char* ws; };

DI float bf_lo(unsigned u) { return __uint_as_float(u << 16); }
DI float bf_hi(unsigned u) { return __uint_as_float(u & 0xffff0000u); }
DI float bf2f(bf16_t v) { return __uint_as_float((unsigned)v << 16); }
DI unsigned pk2(float lo, float hi) { f32x2 v = {lo, hi}; bf16x2_t b = __builtin_convertvector(v, bf16x2_t); return __builtin_bit_cast(unsigned, b); }
DI bf16_t f2bf(float f) { return (bf16_t)(pk2(f, 0.f) & 0xffffu); }
DI float wave_sum(float v) {
#pragma unroll
    for (int o = 32; o > 0; o >>= 1) v += __shfl_xor(v, o);
    return v;
}
DI float sigmoidf_(float x) { return __builtin_amdgcn_rcpf(1.f + __expf(-x)); }
DI float siluf_(float x) { return x * __builtin_amdgcn_rcpf(1.f + __expf(-x)); }
DI int crow(int reg, int h) { return (reg & 3) + 8 * (reg >> 2) + 4 * h; }
namespace pg8 {
#define PG8_LAS __attribute__((address_space(3)))
typedef unsigned short bf16_t;
typedef short bf16x8 __attribute__((ext_vector_type(8)));
typedef float f32x4 __attribute__((ext_vector_type(4)));
typedef unsigned u32x4 __attribute__((ext_vector_type(4)));
constexpr int BM = 256, BK = 64, HALF = 128, HTB = HALF * BK * 2  , STAGE_BYTES = 8 * HTB, NXCD = 8, WGM = 8;

__host__ __device__ __forceinline__ int lds_byte(int r, int c) { const int st = (r >> 4) * 2 + (c >> 5), rr = r & 15, cc = c & 31, ob = rr * 64 + cc * 2; return st * 1024 + (ob ^ (((ob >> 9) & 1) << 5)); }
__host__ __device__ __forceinline__ void stage_rc(int b, int& R, int& C) { const int st = b / 1024, sb = b % 1024, swz = sb ^ (((sb >> 9) & 1) << 5); R = (st >> 1) * 16 + swz / 64; C = (st & 1) * 32 + (swz % 64) / 2; }
__host__ __device__ __forceinline__ int perm32(int rho) { const int n = rho >> 4, i = rho & 15; return 8 * (i >> 2) + 4 * n + (i & 3); }

struct Unit { int pm, pn; };
struct Gemm { const bf16_t* A; const bf16_t* Bt; int M, N, K; };

struct StaticOrder {
    int nM, nN, nwg, G, c;
    __host__ __device__ void init(int M, int N, int G_, int c_) { nM = M / BM; nN = N / BM; nwg = nM * nN; G = G_; c = c_; }
    __host__ __device__ bool next(int i, Unit& u) const {
        const long L = (long)i * G + c; if (L >= nwg) return false;
        int wgid = (int)L; { const int q = nwg / NXCD, r = nwg % NXCD, xcd = wgid % NXCD, off = wgid / NXCD; wgid = (xcd < r ? xcd * (q + 1) : r * (q + 1) + (xcd - r) * q) + off; }
        const int nig = WGM * nN, gid = wgid / nig, fm = gid * WGM, gsz = (nM - fm) < WGM ? (nM - fm) : WGM;
        u.pm = fm + ((wgid % nig) % gsz); u.pn = (wgid % nig) / gsz; return true;
    }
    __device__ __forceinline__ void a_ready(const Unit&) const {}
    __device__ __forceinline__ void done(const Unit&) const {}
};
typedef float pk_f32x2 __attribute__((ext_vector_type(2)));
typedef __bf16 pk_bf16x2 __attribute__((ext_vector_type(2)));
__device__ __forceinline__ unsigned cvt_pk_bf16(float lo, float hi) { pk_f32x2 v = {lo, hi}; pk_bf16x2 b = __builtin_convertvector(v, pk_bf16x2); return __builtin_bit_cast(unsigned, b); }

template <int MODE> struct EpiT {
    static constexpr bool PERM = true, AFTER_DRAIN = false, PERMA = false;
    bf16_t* O; int ldc; const bf16_t* G;
    __device__ __forceinline__ void operator()(const f32x4 (&acc)[2][2][4][2], const Unit& u, int wr, int wc, int fr, int fq) const {
        const int row0 = u.pm * BM + wr * 64 + fr, col0 = u.pn * BM + wc * 32 + 8 * fq;
#pragma unroll
        for (int ai = 0; ai < 2; ++ai)
#pragma unroll
            for (int m = 0; m < 4; ++m) {
                const size_t roff = (size_t)(row0 + ai * HALF + m * 16) * ldc + col0;
#pragma unroll
                for (int bj = 0; bj < 2; ++bj) {
                    f32x4 v0 = acc[ai][bj][m][0], v1 = acc[ai][bj][m][1];
                    const size_t off = roff + bj * HALF;
                    if (MODE == 1) {
#pragma unroll
                        for (int j = 0; j < 4; ++j) { v0[j] = __builtin_amdgcn_rcpf(1.f + __expf(-v0[j])); v1[j] = __builtin_amdgcn_rcpf(1.f + __expf(-v1[j])); }
                    }
                    if (MODE == 2 || MODE == 3) {
                        const u32x4 g = *(const u32x4*)(G + off);
                        v0[0] *= __uint_as_float(g.x << 16); v0[1] *= __uint_as_float(g.x & 0xffff0000u);
                        v0[2] *= __uint_as_float(g.y << 16); v0[3] *= __uint_as_float(g.y & 0xffff0000u);
                        v1[0] *= __uint_as_float(g.z << 16); v1[1] *= __uint_as_float(g.z & 0xffff0000u);
                        v1[2] *= __uint_as_float(g.w << 16); v1[3] *= __uint_as_float(g.w & 0xffff0000u);
                    }
                    if (MODE == 3) {
                        const u32x4 o = *(const u32x4*)(O + off);
                        v0[0] += __uint_as_float(o.x << 16); v0[1] += __uint_as_float(o.x & 0xffff0000u);
                        v0[2] += __uint_as_float(o.y << 16); v0[3] += __uint_as_float(o.y & 0xffff0000u);
                        v1[0] += __uint_as_float(o.z << 16); v1[1] += __uint_as_float(o.z & 0xffff0000u);
                        v1[2] += __uint_as_float(o.w << 16); v1[3] += __uint_as_float(o.w & 0xffff0000u);
                    }
                    u32x4 w; w.x = cvt_pk_bf16(v0[0], v0[1]); w.y = cvt_pk_bf16(v0[2], v0[3]); w.z = cvt_pk_bf16(v1[0], v1[1]); w.w = cvt_pk_bf16(v1[2], v1[3]);
                    *(u32x4*)(O + off) = w;
                }
            }
    }
};

__device__ __forceinline__ float dpp_row_shr1(float x) { return __builtin_bit_cast(float, __builtin_amdgcn_update_dpp(0, __builtin_bit_cast(int, x), 0x111, 0xf, 0xf, true)); }
__device__ __forceinline__ float dpp_row_shl1(float x) { return __builtin_bit_cast(float, __builtin_amdgcn_update_dpp(0, __builtin_bit_cast(int, x), 0x101, 0xf, 0xf, true)); }
struct EpiFfn {
    static constexpr bool PERM = true, AFTER_DRAIN = false, PERMA = true;
    bf16_t* ACT; bf16_t* EDGE; const float* cw; const float* cb; PG8_LAS float* X;
    __device__ __forceinline__ void operator()(const f32x4 (&acc)[2][2][4][2], const Unit& u, int wr, int wc, int fr, int fq) const {
        const int ch0 = u.pn * 128 + wc * 32 + 8 * fq, tau0 = wr * 128 + fr * 8, xo = ((wc * 4 + fq) * 2) * 8;
        if (wr == 0 && fr == 15) {
#pragma unroll
            for (int bj = 0; bj < 2; ++bj)
#pragma unroll
                for (int n = 0; n < 2; ++n) *(PG8_LAS f32x4*)(X + xo + bj * 8 + 4 * n) = acc[1][bj][3][n];
        }
        if (wr == 1 && fr == 0) {
#pragma unroll
            for (int bj = 0; bj < 2; ++bj)
#pragma unroll
                for (int n = 0; n < 2; ++n) *(PG8_LAS f32x4*)(X + 256 + xo + bj * 8 + 4 * n) = acc[0][bj][0][n];
        }
        asm volatile("s_waitcnt lgkmcnt(0)\n\ts_barrier" ::: "memory");
        const bool lo_edge = (wr == 0 && fr == 0), hi_edge = (wr == 1 && fr == 15);
#pragma unroll
        for (int n = 0; n < 2; ++n) {
            const int c4 = ch0 + 4 * n;
            f32x4 wa[3], wb[3];
#pragma unroll
            for (int tp = 0; tp < 3; ++tp) { wa[tp] = *(const f32x4*)(cw + tp * 5632 + c4); wb[tp] = *(const f32x4*)(cw + tp * 5632 + 2816 + c4); }
            const f32x4 ba = *(const f32x4*)(cb + c4), bb = *(const f32x4*)(cb + 2816 + c4);
            f32x4 pa, pb, na, nb;
#pragma unroll
            for (int j = 0; j < 4; ++j) {
                pa[j] = dpp_row_shr1(acc[1][0][3][n][j]); pb[j] = dpp_row_shr1(acc[1][1][3][n][j]);
                na[j] = dpp_row_shl1(acc[0][0][0][n][j]); nb[j] = dpp_row_shl1(acc[0][1][0][n][j]);
            }
            if (fr == 0 && wr == 1) { pa = *(const PG8_LAS f32x4*)(X + xo + 4 * n); pb = *(const PG8_LAS f32x4*)(X + xo + 8 + 4 * n); }
            if (fr == 15 && wr == 0) { na = *(const PG8_LAS f32x4*)(X + 256 + xo + 4 * n); nb = *(const PG8_LAS f32x4*)(X + 256 + xo + 8 + 4 * n); }
#pragma unroll
            for (int q = 0; q < 8; ++q) {
                const f32x4 ap = (q == 0) ? pa : acc[(q - 1 < 0 ? 0 : q - 1) >> 2][0][(q - 1 < 0 ? 0 : q - 1) & 3][n];
                const f32x4 bp = (q == 0) ? pb : acc[(q - 1 < 0 ? 0 : q - 1) >> 2][1][(q - 1 < 0 ? 0 : q - 1) & 3][n];
                const f32x4 an = (q == 7) ? na : acc[(q + 1 > 7 ? 7 : q + 1) >> 2][0][(q + 1 > 7 ? 7 : q + 1) & 3][n];
                const f32x4 bn = (q == 7) ? nb : acc[(q + 1 > 7 ? 7 : q + 1) >> 2][1][(q + 1 > 7 ? 7 : q + 1) & 3][n];
                const f32x4 ac = acc[q >> 2][0][q & 3][n], bc = acc[q >> 2][1][q & 3][n];
                const f32x4 ua = ap * wa[0] + ac * wa[1] + an * wa[2] + ba, ub = bp * wb[0] + bc * wb[1] + bn * wb[2] + bb;
                float o[4];
#pragma unroll
                for (int j = 0; j < 4; ++j) o[j] = ua[j] * __builtin_amdgcn_rcpf(1.f + __expf(-ua[j])) * ub[j];
                const bool valid = !((q == 0 && lo_edge) || (q == 7 && hi_edge));
                if (valid) { pk_f32x2 w2; unsigned lo = cvt_pk_bf16(o[0], o[1]), hi = cvt_pk_bf16(o[2], o[3]); (void)w2;
                    typedef unsigned u32x2_t __attribute__((ext_vector_type(2)));
                    *(u32x2_t*)(ACT + (size_t)(u.pm * BM + tau0 + q) * 2816 + c4) = (u32x2_t){lo, hi}; }
            }
        }
        if (lo_edge || hi_edge) {
            const int e0 = lo_edge ? 0 : 2, ai = lo_edge ? 0 : 1;
#pragma unroll
            for (int e = 0; e < 2; ++e)
#pragma unroll
                for (int bj = 0; bj < 2; ++bj) {
                    const f32x4 v0 = lo_edge ? acc[0][bj][e][0] : acc[1][bj][2 + e][0], v1 = lo_edge ? acc[0][bj][e][1] : acc[1][bj][2 + e][1];
                    u32x4 w; w.x = cvt_pk_bf16(v0[0], v0[1]); w.y = cvt_pk_bf16(v0[2], v0[3]); w.z = cvt_pk_bf16(v1[0], v1[1]); w.w = cvt_pk_bf16(v1[2], v1[3]);
                    *(u32x4*)(EDGE + ((size_t)u.pm * 4 + e0 + e) * 5632 + bj * 2816 + ch0) = w;
                }
            (void)ai;
        }
    }
};
template <class Epi, class Sched, bool ALIGN_EPI = false, bool SP2 = false>
__device__ __forceinline__ void gemm_phase(PG8_LAS unsigned char* lds, const Gemm g, const Sched& S, const Epi& E) {
    int tid_l = threadIdx.x; asm volatile("" : "+v"(tid_l));
    const int tid = tid_l, wid = __builtin_amdgcn_readfirstlane(tid >> 6), lane = tid & 63, wr = wid >> 2, wc = wid & 3, fr = lane & 15, fq = lane >> 4;
    const int K = g.K, nt = K / BK;
    unsigned voffA[2], voffB[2];
#pragma unroll
    for (int i = 0; i < 2; ++i) { int R, C; stage_rc(tid * 16 + i * 8192, R, C); const int Rb = Epi::PERM ? ((R & ~31) + perm32(R & 31)) : R;
        const int Ra = Epi::PERMA ? ((R >> 6) * 128 + (R & 15) * 8 + ((R >> 4) & 3)) : R;
        voffA[i] = (unsigned)(Ra * K + C) * 2u; voffB[i] = (unsigned)(Rb * K + C) * 2u; }
    const size_t kstep = (size_t)(BK * 2);
    const size_t hstep = (size_t)HALF * K * 2;
    const size_t hstepA = Epi::PERMA ? (size_t)4 * K * 2 : hstep;
    const size_t tstep = 2 * hstep;
    const unsigned ldsw = (unsigned)wid * 1024u;
    const int aoff = lds_byte(wr * 64 + fr, fq * 8), boff = lds_byte(wc * 32 + fr, fq * 8);
#define PG8_SA(b, h) (((b) * 2 + (h)) * HTB)
#define PG8_SB(b, h) ((4 + (b) * 2 + (h)) * HTB)
#define PG8_STAGE(bufoff, gbase, voff) do { _Pragma("unroll") for (int _i = 0; _i < 2; ++_i) \
        __builtin_amdgcn_global_load_lds((const unsigned*)((const char*)(gbase) + (voff)[_i]), (PG8_LAS unsigned*)(lds + (bufoff) + ldsw + _i * 8192), 16, 0, 0); } while (0)
#define PG8_LDA(dst, b, h) do { _Pragma("unroll") for (int m = 0; m < 4; ++m) _Pragma("unroll") for (int k = 0; k < 2; ++k) dst[m][k] = *(const PG8_LAS bf16x8*)(lds + PG8_SA(b, h) + aoff + m * 2048 + k * 1024); } while (0)
#define PG8_LDB(dst, b, h) do { _Pragma("unroll") for (int n = 0; n < 2; ++n) _Pragma("unroll") for (int k = 0; k < 2; ++k) dst[n][k] = *(const PG8_LAS bf16x8*)(lds + PG8_SB(b, h) + boff + n * 2048 + k * 1024); } while (0)
#define PG8_MMA(ai, bj, At, Bt) do { __builtin_amdgcn_s_setprio(1); _Pragma("unroll") for (int m = 0; m < 4; ++m) _Pragma("unroll") for (int n = 0; n < 2; ++n) _Pragma("unroll") for (int k = 0; k < 2; ++k) \
        acc[ai][bj][m][n] = __builtin_amdgcn_mfma_f32_16x16x32_bf16(Bt[n][k], At[m][k], acc[ai][bj][m][n], 0, 0, 0); __builtin_amdgcn_s_setprio(0); } while (0)
#define PG8_WAIT_V(n) asm volatile("s_waitcnt vmcnt(" #n ")" ::: "memory")
#define PG8_WAIT_L(n) asm volatile("s_waitcnt lgkmcnt(" #n ")" ::: "memory")
#define PG8_BAR __builtin_amdgcn_s_barrier()
#define PG8_SCHED __builtin_amdgcn_sched_barrier(0)
    Unit cur, nxt; int ui = 0;
    if (!S.next(0, cur)) return;
    f32x4 acc[2][2][4][2];
#pragma unroll
    for (int a = 0; a < 2; ++a)
#pragma unroll
        for (int b = 0; b < 2; ++b)
#pragma unroll
            for (int m = 0; m < 4; ++m)
#pragma unroll
                for (int n = 0; n < 2; ++n) acc[a][b][m][n] = (f32x4){0.f, 0.f, 0.f, 0.f};
    bf16x8 At[4][2], B0[2][2], B1[2][2];
    const char* cA = (const char*)g.A + (size_t)cur.pm * tstep; const char* cB = (const char*)g.Bt + (size_t)cur.pn * tstep;
    S.a_ready(cur);
    if constexpr (SP2) {
        PG8_STAGE(PG8_SB(0, 0), cB, voffB); PG8_STAGE(PG8_SB(0, 1), cB + hstep, voffB); PG8_STAGE(PG8_SA(0, 0), cA, voffA); PG8_STAGE(PG8_SA(0, 1), cA + hstepA, voffA);
        if (wr == 1) PG8_BAR;
        PG8_WAIT_V(2); PG8_BAR;
        PG8_STAGE(PG8_SB(1, 0), cB + kstep, voffB); PG8_STAGE(PG8_SA(1, 0), cA + kstep, voffA); PG8_STAGE(PG8_SB(1, 1), cB + hstep + kstep, voffB);
        PG8_WAIT_V(6); PG8_BAR;
    } else {
        PG8_STAGE(PG8_SB(0, 0), cB, voffB); PG8_STAGE(PG8_SA(0, 0), cA, voffA); PG8_STAGE(PG8_SB(0, 1), cB + hstep, voffB); PG8_STAGE(PG8_SA(0, 1), cA + hstepA, voffA);
        if (wr == 1) PG8_BAR;
        PG8_WAIT_V(4); PG8_BAR;
        PG8_STAGE(PG8_SB(1, 0), cB + kstep, voffB); PG8_STAGE(PG8_SA(1, 0), cA + kstep, voffA); PG8_STAGE(PG8_SB(1, 1), cB + hstep + kstep, voffB);
        PG8_WAIT_V(6); PG8_BAR;
    }
    for (;;) {
        const bool has_next = S.next(ui + 1, nxt);
        const char* nA = has_next ? (const char*)g.A + (size_t)nxt.pm * tstep : cA; const char* nB = has_next ? (const char*)g.Bt + (size_t)nxt.pn * tstep : cB;
        for (int t = 0; t < nt; t += 2) {
            const bool last = (t == nt - 2);
            const char* a1 = cA + (size_t)(t + 1) * kstep;
            const char* a2 = last ? nA : cA + (size_t)(t + 2) * kstep; const char* b2 = last ? nB : cB + (size_t)(t + 2) * kstep;
            const char* a3 = a2 + kstep; const char* b3 = b2 + kstep;
            if (last && has_next) S.a_ready(nxt);
            if constexpr (SP2) {
            PG8_LDB(B0, 0, 0); PG8_LDB(B1, 0, 1); PG8_SCHED; PG8_LDA(At, 0, 0); PG8_STAGE(PG8_SA(1, 1), a1 + hstepA, voffA);
            PG8_WAIT_V(8); PG8_WAIT_L(0); PG8_BAR; PG8_MMA(0, 0, At, B0); PG8_MMA(0, 1, At, B1); PG8_BAR; PG8_SCHED;
            PG8_LDA(At, 0, 1); PG8_STAGE(PG8_SB(0, 0), b2, voffB); PG8_STAGE(PG8_SB(0, 1), b2 + hstep, voffB); PG8_STAGE(PG8_SA(0, 0), a2, voffA);
            PG8_WAIT_V(8); PG8_WAIT_L(0); PG8_BAR; PG8_MMA(1, 0, At, B0); PG8_MMA(1, 1, At, B1); PG8_BAR; PG8_SCHED;
            PG8_LDB(B0, 1, 0); PG8_LDB(B1, 1, 1); PG8_SCHED; PG8_LDA(At, 1, 0); PG8_STAGE(PG8_SA(0, 1), a2 + hstepA, voffA);
            PG8_WAIT_V(8); PG8_WAIT_L(0); PG8_BAR; PG8_MMA(0, 0, At, B0); PG8_MMA(0, 1, At, B1); PG8_BAR; PG8_SCHED;
            PG8_LDA(At, 1, 1); PG8_STAGE(PG8_SB(1, 0), b3, voffB); PG8_STAGE(PG8_SB(1, 1), b3 + hstep, voffB); PG8_STAGE(PG8_SA(1, 0), a3, voffA);
            PG8_WAIT_V(8); PG8_WAIT_L(0); PG8_BAR; PG8_MMA(1, 0, At, B0); PG8_MMA(1, 1, At, B1); PG8_BAR; PG8_SCHED;
            } else {
            PG8_LDB(B0, 0, 0); PG8_SCHED; PG8_LDA(At, 0, 0); PG8_STAGE(PG8_SA(1, 1), a1 + hstepA, voffA);
            PG8_WAIT_L(8); PG8_BAR; PG8_WAIT_L(0); PG8_MMA(0, 0, At, B0); PG8_BAR; PG8_SCHED;
            PG8_LDB(B1, 0, 1); PG8_STAGE(PG8_SB(0, 0), b2, voffB);
            PG8_BAR; PG8_WAIT_L(0); PG8_MMA(0, 1, At, B1); PG8_BAR;
            PG8_LDA(At, 0, 1); PG8_STAGE(PG8_SA(0, 0), a2, voffA);
            PG8_BAR; PG8_WAIT_L(0); PG8_MMA(1, 0, At, B0); PG8_BAR; PG8_SCHED;
            PG8_STAGE(PG8_SB(0, 1), b2 + hstep, voffB);
            PG8_WAIT_V(6); PG8_BAR; PG8_MMA(1, 1, At, B1); PG8_BAR;
            PG8_LDB(B0, 1, 0); PG8_SCHED; PG8_LDA(At, 1, 0); PG8_STAGE(PG8_SA(0, 1), a2 + hstepA, voffA);
            PG8_WAIT_L(8); PG8_BAR; PG8_WAIT_L(0); PG8_MMA(0, 0, At, B0); PG8_BAR; PG8_SCHED;
            PG8_LDB(B1, 1, 1); PG8_STAGE(PG8_SB(1, 0), b3, voffB);
            PG8_BAR; PG8_WAIT_L(0); PG8_MMA(0, 1, At, B1); PG8_BAR;
            PG8_LDA(At, 1, 1); PG8_STAGE(PG8_SA(1, 0), a3, voffA);
            PG8_BAR; PG8_WAIT_L(0); PG8_MMA(1, 0, At, B0); PG8_BAR; PG8_SCHED;
            PG8_STAGE(PG8_SB(1, 1), b3 + hstep, voffB);
            PG8_WAIT_V(6); PG8_BAR; PG8_MMA(1, 1, At, B1); PG8_BAR;
            }
        }
        if constexpr (ALIGN_EPI) { if (wr == 0) PG8_BAR; }
        if constexpr (!Epi::AFTER_DRAIN) { E(acc, cur, wr, wc, fr, fq); S.done(cur); }
        if (!has_next) break;
#pragma unroll
        for (int a = 0; a < 2; ++a)
#pragma unroll
            for (int b = 0; b < 2; ++b)
#pragma unroll
                for (int m = 0; m < 4; ++m)
#pragma unroll
                    for (int n = 0; n < 2; ++n) acc[a][b][m][n] = (f32x4){0.f, 0.f, 0.f, 0.f};
        cur = nxt; cA = nA; cB = nB; ++ui;
        if constexpr (ALIGN_EPI) { if (wr == 1) PG8_BAR; }
    }
    PG8_WAIT_V(0);
    if constexpr (!ALIGN_EPI) { if (wr == 0) PG8_BAR; }
    PG8_BAR;
    if constexpr (Epi::AFTER_DRAIN) { E.fused(acc, cur, wr, wc, fr, fq, lds, wid, lane); S.done(cur); }
#undef PG8_SA
#undef PG8_SB
#undef PG8_STAGE
#undef PG8_LDA
#undef PG8_LDB
#undef PG8_MMA
#undef PG8_WAIT_V
#undef PG8_WAIT_L
#undef PG8_BAR
#undef PG8_SCHED
}
}
#define XB_TMO      128
#define XB_XCNT(j)  (256  + 64 * (j))
#define XB_XSUB(j)  (1280 + 64 * (j))
#define XB_XGEN(j)  (2304 + 64 * (j))
#define XB_TOP      3328
#define XB_TOPGEN   3392
#define XCD_BAR_WORDS 3456
#define XB_SPIN_CAP (1u << 18)

__device__ __forceinline__ unsigned xb_ld(unsigned* p)              { return __hip_atomic_load(p, __ATOMIC_RELAXED, __HIP_MEMORY_SCOPE_AGENT); }
__device__ __forceinline__ unsigned xb_add(unsigned* p, unsigned v) { return __hip_atomic_fetch_add(p, v, __ATOMIC_RELAXED, __HIP_MEMORY_SCOPE_AGENT); }
__device__ __forceinline__ unsigned xb_xcc_id() { return (unsigned)__builtin_amdgcn_s_getreg((3 << 11) | 20) & 0xFu; }
#define XB_SPIN(cond, bar) do { unsigned _sp = 0; while (cond) { __builtin_amdgcn_s_sleep(1); \
    if ((++_sp & 255u) == 0u) { if (xb_ld(&(bar)[XB_TMO])) break; if (_sp > XB_SPIN_CAP) { atomicAdd(&(bar)[XB_TMO], 1u); break; } } } } while (0)

struct XcdBarrier {
    unsigned* bar; unsigned x;
    volatile LAS unsigned* st;
};

__device__ __forceinline__ XcdBarrier xcd_barrier_post(unsigned* bar, volatile LAS unsigned* st) {
    XcdBarrier b; b.bar = bar; b.x = xb_xcc_id(); b.st = st;
    if (threadIdx.x == 0) (void)xb_add(&bar[XB_XCNT(b.x)], 1u);
    return b;
}
__device__ __forceinline__ void xcd_barrier_complete(unsigned* bar, unsigned x, unsigned& nloc, unsigned& nx) {
    const unsigned G = gridDim.x * gridDim.y * gridDim.z;
    unsigned sum, cnt, mine, sp = 0u;
    for (;;) {
        sum = 0u; cnt = 0u; mine = 0u;
#pragma unroll
        for (unsigned j = 0; j < 16; ++j) { const unsigned c = xb_ld(&bar[XB_XCNT(j)]); sum += c; cnt += (c > 0u) ? 1u : 0u; mine = (j == x) ? c : mine; }
        if (sum == G) break;
        __builtin_amdgcn_s_sleep(1);
        if ((++sp & 255u) == 0u) { if (xb_ld(&bar[XB_TMO])) break; if (sp > XB_SPIN_CAP) { atomicAdd(&bar[XB_TMO], 1u); break; } }
    }
    nloc = mine > 0u ? mine : 1u; nx = cnt > 0u ? cnt : 1u;
}

__device__ __forceinline__ void xcd_barrier(const XcdBarrier& b) {
    asm volatile("s_waitcnt vmcnt(0)" ::: "memory");
    __syncthreads();
    if (threadIdx.x == 0) {
        unsigned* bar = b.bar;
        __builtin_amdgcn_s_waitcnt(0);
        unsigned nloc = b.st[0], nx = b.st[1];
        if (nloc == 0u) { xcd_barrier_complete(bar, b.x, nloc, nx); b.st[0] = nloc; b.st[1] = nx; }
        const unsigned old = xb_add(&bar[XB_XSUB(b.x)], 1u);
        const unsigned gen = old / nloc;
        if (old + 1u == (gen + 1u) * nloc) {
            __builtin_amdgcn_fence(__ATOMIC_RELEASE, "agent");
            asm volatile("s_waitcnt vmcnt(0)" ::: "memory");
            const unsigned og = xb_add(&bar[XB_TOP], 1u);
            const unsigned tg = og / nx;
            if (og + 1u == (tg + 1u) * nx) xb_add(&bar[XB_TOPGEN], 1u);
            else XB_SPIN(xb_ld(&bar[XB_TOPGEN]) == tg, bar);
            __builtin_amdgcn_fence(__ATOMIC_ACQUIRE, "agent");
            xb_add(&bar[XB_XGEN(b.x)], 1u);
            asm volatile("s_waitcnt vmcnt(0)" ::: "memory");
        } else {
            XB_SPIN(xb_ld(&bar[XB_XGEN(b.x)]) == gen, bar);
            __builtin_amdgcn_fence(__ATOMIC_ACQUIRE, "agent");
            asm volatile("s_waitcnt vmcnt(0)" ::: "memory");
        }
    }
    __syncthreads();
}


typedef const __attribute__((address_space(4))) Params* ParamsPtr;
struct Ctx { ParamsPtr pp; int bid, nb, tid, wave, lane; unsigned char* lds; };


DI float4 nt_load4(const float* p) { const f32x4 v = __builtin_nontemporal_load((const f32x4*)p); return make_float4(v[0], v[1], v[2], v[3]); }
DI void nt_store4(float* p, float4 o) { const f32x4 v = {o.x, o.y, o.z, o.w}; __builtin_nontemporal_store(v, (f32x4*)p); }
DI void lds_barrier() { asm volatile("s_waitcnt lgkmcnt(0)\n\ts_barrier" ::: "memory"); }
DI Ctx relaunder(const Ctx& c0) {
    Ctx c = c0; asm volatile("" : "+v"(c.tid)); c.lane = c.tid & 63; c.wave = __builtin_amdgcn_readfirstlane(c.tid >> 6); return c;
}
DI const float* mods_ptr(const Ctx& c, int l, int mrow) { return (const float*)(c.pp->ws + WS_MODS) + (size_t)(l * 33 + mrow) * 6144; }
DI bf16_t* wptr(const Ctx& c, int l, size_t off) { return (bf16_t*)(c.pp->ws + WS_W + (size_t)l * SZ_WL + off); }

DI void convert_tile4(const float* __restrict__ src, bf16_t* __restrict__ dst, int K, int N, int tile4, float* lds, int tid, bool up_perm = false) {
    const int ntn = N >> 8, tk = tile4 / ntn, tn = tile4 % ntn;
    const int c4 = (tid & 63) * 4, r0 = tid >> 6;
    float4 v[8];
#pragma unroll
    for (int i = 0; i < 8; ++i) v[i] = *(const float4*)(src + (size_t)(tk * 64 + r0 + 8 * i) * N + tn * 256 + c4);
#pragma unroll
    for (int i = 0; i < 8; ++i) { float* q = lds + (r0 + 8 * i) * 257 + c4; q[0] = v[i].x; q[1] = v[i].y; q[2] = v[i].z; q[3] = v[i].w; }
    __syncthreads();
    const int n = tid >> 1, kh = (tid & 1) * 32;
    int drow = tn * 256 + n;
    if (up_perm) { const int part = drow / DFF, ch = drow % DFF; drow = (ch >> 7) * 256 + part * 128 + (ch & 127); }
    bf16_t* dp = dst + (size_t)drow * K + tk * 64 + kh;
#pragma unroll
    for (int q = 0; q < 4; ++q) {
        const float* lp = lds + (kh + 8 * q) * 257 + n;
        u32x4 w;
        w.x = pk2(lp[0], lp[257]); w.y = pk2(lp[2 * 257], lp[3 * 257]); w.z = pk2(lp[4 * 257], lp[5 * 257]); w.w = pk2(lp[6 * 257], lp[7 * 257]);
        *(u32x4*)(dp + 8 * q) = w;
    }
    __syncthreads();
}

DI void adaln_item(const Ctx& c, int item) {
    float* lds = (float*)c.lds;
    const int l = item / 96, cgp = item % 96, tid = c.tid;
    for (int i = tid; i < 33 * 1024; i += NTHREADS) { const int r = i >> 10, k = i & 1023; const float v = (r < 32) ? c.pp->in[1][r * 1024 + k] : c.pp->in[3][k]; lds[i] = siluf_(v); }
    __syncthreads();
    const int cl = tid & 63, ks = tid >> 6, col = cgp * 64 + cl;
    const float* W = c.pp->in[4] + (size_t)l * 1024 * 6144 + col;
    float acc[33];
#pragma unroll
    for (int r = 0; r < 33; ++r) acc[r] = 0.f;
    for (int k = ks * 128; k < ks * 128 + 128; k += 4) {
        const float w0 = W[(size_t)k * 6144], w1 = W[(size_t)(k + 1) * 6144], w2 = W[(size_t)(k + 2) * 6144], w3 = W[(size_t)(k + 3) * 6144];
#pragma unroll
        for (int r = 0; r < 33; ++r) { const float4 s = *(const float4*)(lds + r * 1024 + k); acc[r] += s.x * w0 + s.y * w1 + s.z * w2 + s.w * w3; }
    }
    __syncthreads();
#pragma unroll
    for (int r = 0; r < 33; ++r) lds[(ks * 33 + r) * 64 + cl] = acc[r];
    __syncthreads();
    float* mods = (float*)(c.pp->ws + WS_MODS);
    for (int i = tid; i < 33 * 64; i += NTHREADS) {
        const int r = i >> 6, cc = i & 63; float s = 0.f;
#pragma unroll
        for (int q = 0; q < 8; ++q) s += lds[(q * 33 + r) * 64 + cc];
        const int gc = cgp * 64 + cc;
        mods[(size_t)(l * 33 + r) * 6144 + gc] = s + c.pp->in[5][l * 6144 + gc];
    }
    __syncthreads();
}

DI void hyfilt_item(const Ctx& c, int item) {
    const int lane = c.lane;
    const int pi = item * 8 + c.wave;
    int l, Lx, pos; bool isctx;
    if (pi < 2048) { l = 0; Lx = 2048; pos = pi; isctx = false; }
    else if (pi < 4096) { l = 1; Lx = 2048; pos = pi - 2048; isctx = false; }
    else { l = 0; Lx = 256; pos = pi - 4096; isctx = true; }
    const float tl = (float)pos / (float)(Lx - 1);
    const float w = (6.2831855f * (float)pos) / (float)Lx;
    float zv = 0.f;
    if (lane == 0) zv = tl;
    else if (lane <= 16) { const float f = 1e-4f + (float)(lane - 1) * ((15.f - 1e-4f) / 15.f); zv = cosf(f * w); }
    else if (lane <= 32) { const float f = 1e-4f + (float)(lane - 17) * ((15.f - 1e-4f) / 15.f); zv = -sinf(f * w); }
    const float* w1 = c.pp->in[17] + l * 33 * 64; const float* b1 = c.pp->in[18] + l * 64; const float* wi = c.pp->in[19] + l * 2 * 64 * 64;
    const float* bi = c.pp->in[20] + l * 2 * 64; const float* fr = c.pp->in[21] + l * 64; const float* wl = c.pp->in[22] + (size_t)l * 64 * 1024;
    const float* bias = c.pp->in[23] + l * 512;
    const float frq = fr[lane];
    float a = b1[lane];
    for (int i = 0; i < 33; ++i) a += __shfl(zv, i) * w1[i * 64 + lane];
    float h = sinf(frq * a);
    for (int j = 0; j < 2; ++j) {
        float a2 = bi[j * 64 + lane];
        for (int k = 0; k < 64; ++k) a2 += __shfl(h, k) * wi[(j * 64 + k) * 64 + lane];
        h = sinf(frq * a2);
    }
    float o[16];
#pragma unroll
    for (int i = 0; i < 16; ++i) o[i] = 0.f;
    for (int k = 0; k < 64; ++k) {
        const float hk = __shfl(h, k); const float* r = wl + k * 1024 + lane;
#pragma unroll
        for (int i = 0; i < 16; ++i) o[i] += hk * r[64 * i];
    }
    const float MIN_D = -3.0701134573253944f, MAX_D = -15.350567286626973f;
#pragma unroll
    for (int i = 0; i < 8; ++i) {
        const int ch = lane + 64 * i;
        const float delta = fabsf(MIN_D + (MAX_D - MIN_D) * ((float)ch / 511.f));
        const float dec = expf(-tl * delta);
        const float hf = o[i] * dec, hb = o[i + 8] * dec;
        if (!isctx) {
            bf16_t* R = (bf16_t*)(c.pp->ws + WS_RL) + ((size_t)l * 512 + ch) * 4096;
            if (pos == 0) { R[2048] = f2bf(hf + hb + bias[ch]); R[0] = 0; } else { R[2048 - pos] = f2bf(hf); R[2048 + pos] = f2bf(hb); }
        } else {
            float* R = (float*)(c.pp->ws + WS_RC) + (size_t)ch * 512;
            if (pos == 0) { R[256] = hf + hb + bias[ch]; R[0] = 0.f; } else { R[256 + pos] = hf; R[256 - pos] = hb; }
        }
    }
}

DI void rope_item(const Ctx& c, int item) {
    const int idx = item * NTHREADS + c.tid, t = idx >> 5, ip = idx & 31;
    const int row = t >> 6, col = t & 63, j = ip & 15;
    const float inv = powf(10000.f, -(float)j / 16.f);
    const float ang = (float)(ip < 16 ? row : col) * inv;
    float* R = (float*)(c.pp->ws + WS_ROPE);
    R[(size_t)idx * 2] = cosf(ang); R[(size_t)idx * 2 + 1] = sinf(ang);
}

constexpr int CV_PER_LAYER = (1984 + 384 + 256 + 1408 + 704) / 4;
DI void phase_prologue(const Ctx& c0) {
    const int N_ADA = 192, N_HYF = 544, N_ROPE = 128, N_CV = 2 * CV_PER_LAYER;
    const int total = N_ADA + N_HYF + N_ROPE + N_CV;
    for (int it = c0.bid; it < total; it += c0.nb) {
        const Ctx c = relaunder(c0);
        if (it < N_ADA) { adaln_item(c, it); continue; }
        int i = it - N_ADA;
        if (i < N_HYF) { hyfilt_item(c, i); continue; }
        i -= N_HYF;
        if (i < N_ROPE) { rope_item(c, i); continue; }
        i -= N_ROPE;
        const int l = i / CV_PER_LAYER; int t = i % CV_PER_LAYER;
        float* lds = (float*)c.lds;
        if (t < 496) { convert_tile4(c.pp->in[10] + (size_t)l * D * DIN, wptr(c, l, OFF_WIN), D, DIN, t, lds, c.tid); continue; }
        t -= 496;
        if (t < 96) { const int br = t / 32; convert_tile4(c.pp->in[24 + br] + (size_t)l * 512 * D, wptr(c, l, OFF_WO + br * SZ_WO1), 512, D, t % 32, lds, c.tid); continue; }
        t -= 96;
        if (t < 64) { convert_tile4(c.pp->in[27] + (size_t)l * D * D, wptr(c, l, OFF_WOUT), D, D, t, lds, c.tid); continue; }
        t -= 64;
        if (t < 352) { convert_tile4(c.pp->in[28] + (size_t)l * D * NUP, wptr(c, l, OFF_WUP), D, NUP, t, lds, c.tid, true); continue; }
        t -= 352;
        convert_tile4(c.pp->in[31] + (size_t)l * DFF * D, wptr(c, l, OFF_WDN), DFF, D, t, lds, c.tid);
    }
}

DI float* resid_ptr(const Ctx& c, int row) { return row < ML ? c.pp->out + (size_t)row * D : (float*)(c.pp->ws + WS_CTXR) + (size_t)(row - ML) * D; }
DI const float* input_ptr(const Ctx& c, int row) { return row < ML ? c.pp->in[0] + (size_t)row * D : c.pp->in[2] + (size_t)(row - ML) * D; }
DI int mod_row_of(int row) { return row < ML ? (row >> 11) : 32; }

constexpr int RPW = 4;
DI void phase_mod0(const Ctx& c) {
    bf16_t* HX = (bf16_t*)(c.pp->ws + WS_HX);
    const float* g = c.pp->in[6];
    const int rpw0 = ((M + c.nb * 8 * RPW - 1) / (c.nb * 8 * RPW)) * RPW;
    for (int rbase = (c.bid * 8 + c.wave) * rpw0; rbase < (c.bid * 8 + c.wave + 1) * rpw0 && rbase < M; rbase += RPW) {
        float4 v[RPW][4]; float ss[RPW];
#pragma unroll
        for (int r = 0; r < RPW; ++r) {
            const float* xr = input_ptr(c, rbase + r);
#pragma unroll
            for (int i = 0; i < 4; ++i) v[r][i] = nt_load4(xr + i * 256 + c.lane * 4);
        }
#pragma unroll
        for (int r = 0; r < RPW; ++r) {
            ss[r] = 0.f;
#pragma unroll
            for (int i = 0; i < 4; ++i) ss[r] += v[r][i].x * v[r][i].x + v[r][i].y * v[r][i].y + v[r][i].z * v[r][i].z + v[r][i].w * v[r][i].w;
        }
#pragma unroll
        for (int o = 32; o > 0; o >>= 1)
#pragma unroll
            for (int r = 0; r < RPW; ++r) ss[r] += __shfl_xor(ss[r], o);
        const float* md = mods_ptr(c, 0, mod_row_of(rbase));
        float rs[RPW];
#pragma unroll
        for (int r = 0; r < RPW; ++r) rs[r] = rsqrtf(ss[r] * (1.f / 1024.f) + EPS);
#pragma unroll
        for (int i = 0; i < 4; ++i) {
            const int cc = i * 256 + c.lane * 4;
            const float4 gg = *(const float4*)(g + cc), sh = *(const float4*)(md + cc), sc = *(const float4*)(md + 1024 + cc);
            const float4 ms = make_float4(gg.x * (1.f + sc.x), gg.y * (1.f + sc.y), gg.z * (1.f + sc.z), gg.w * (1.f + sc.w));
#pragma unroll
            for (int r = 0; r < RPW; ++r) {
                u32x2 o; o.x = pk2(v[r][i].x * rs[r] * ms.x + sh.x, v[r][i].y * rs[r] * ms.y + sh.y);
                o.y = pk2(v[r][i].z * rs[r] * ms.z + sh.z, v[r][i].w * rs[r] * ms.w + sh.w);
                *(u32x2*)(HX + (size_t)(rbase + r) * D + cc) = o;
            }
        }
    }
}

DI void phase_resid(const Ctx& c, int nrows, const bf16_t* Y, const float* gpost, int lg, int gate_idx, bool from_input, bool do_mod, const float* gmod, int lm, int sh_idx) {
    bf16_t* HX = (bf16_t*)(c.pp->ws + WS_HX);
    const int rpw = ((nrows + c.nb * 8 * RPW - 1) / (c.nb * 8 * RPW)) * RPW;
    for (int rbase = (c.bid * 8 + c.wave) * rpw; rbase < (c.bid * 8 + c.wave + 1) * rpw && rbase < nrows; rbase += RPW) {
        u32x2 yu[RPW][4]; float4 xv[RPW][4]; float ss[RPW], s2[RPW];
#pragma unroll
        for (int r = 0; r < RPW; ++r) {
            const int row = rbase + r;
            const float* xr = from_input ? input_ptr(c, row) : (const float*)resid_ptr(c, row);
#pragma unroll
            for (int i = 0; i < 4; ++i) { yu[r][i] = *(const u32x2*)(Y + (size_t)row * D + i * 256 + c.lane * 4); xv[r][i] = nt_load4(xr + i * 256 + c.lane * 4); }
        }
#pragma unroll
        for (int r = 0; r < RPW; ++r) {
            ss[r] = 0.f;
#pragma unroll
            for (int i = 0; i < 4; ++i) { const float a = bf_lo(yu[r][i].x), b = bf_hi(yu[r][i].x), cq = bf_lo(yu[r][i].y), d = bf_hi(yu[r][i].y); ss[r] += a * a + b * b + cq * cq + d * d; }
        }
#pragma unroll
        for (int o = 32; o > 0; o >>= 1)
#pragma unroll
            for (int r = 0; r < RPW; ++r) ss[r] += __shfl_xor(ss[r], o);
        const int mr = mod_row_of(rbase);
        const float* mg = mods_ptr(c, lg, mr) + gate_idx * 1024;
        float rs[RPW];
#pragma unroll
        for (int r = 0; r < RPW; ++r) { rs[r] = rsqrtf(ss[r] * (1.f / 1024.f) + EPS); s2[r] = 0.f; }
#pragma unroll
        for (int i = 0; i < 4; ++i) {
            const int cc = i * 256 + c.lane * 4;
            const float4 gp = *(const float4*)(gpost + cc), gt = *(const float4*)(mg + cc);
            const float4 gg = make_float4(gt.x * gp.x, gt.y * gp.y, gt.z * gp.z, gt.w * gp.w);
#pragma unroll
            for (int r = 0; r < RPW; ++r) {
                float4 o;
                o.x = xv[r][i].x + gg.x * (bf_lo(yu[r][i].x) * rs[r]); o.y = xv[r][i].y + gg.y * (bf_hi(yu[r][i].x) * rs[r]);
                o.z = xv[r][i].z + gg.z * (bf_lo(yu[r][i].y) * rs[r]); o.w = xv[r][i].w + gg.w * (bf_hi(yu[r][i].y) * rs[r]);
                nt_store4(resid_ptr(c, rbase + r) + cc, o);
                xv[r][i] = o;
                s2[r] += o.x * o.x + o.y * o.y + o.z * o.z + o.w * o.w;
            }
        }
        if (do_mod) {
#pragma unroll
            for (int o = 32; o > 0; o >>= 1)
#pragma unroll
                for (int r = 0; r < RPW; ++r) s2[r] += __shfl_xor(s2[r], o);
            const float* md = mods_ptr(c, lm, mr) + sh_idx * 1024;
            float r2[RPW];
#pragma unroll
            for (int r = 0; r < RPW; ++r) r2[r] = rsqrtf(s2[r] * (1.f / 1024.f) + EPS);
#pragma unroll
            for (int i = 0; i < 4; ++i) {
                const int cc = i * 256 + c.lane * 4;
                const float4 gg = *(const float4*)(gmod + cc), sh = *(const float4*)(md + cc), sc = *(const float4*)(md + 1024 + cc);
                const float4 ms = make_float4(gg.x * (1.f + sc.x), gg.y * (1.f + sc.y), gg.z * (1.f + sc.z), gg.w * (1.f + sc.w));
#pragma unroll
                for (int r = 0; r < RPW; ++r) {
                    u32x2 o; o.x = pk2(xv[r][i].x * r2[r] * ms.x + sh.x, xv[r][i].y * r2[r] * ms.y + sh.y);
                    o.y = pk2(xv[r][i].z * r2[r] * ms.z + sh.z, xv[r][i].w * r2[r] * ms.w + sh.w);
                    *(u32x2*)(HX + (size_t)(rbase + r) * D + cc) = o;
                }
            }
        }
    }
}

struct OneUnitOrder {
    pg8::StaticOrder S; int r;
    __device__ bool next(int i, pg8::Unit& u) const { return i == 0 && S.next(r, u); }
    __device__ __forceinline__ void a_ready(const pg8::Unit&) const {}
    __device__ __forceinline__ void done(const pg8::Unit&) const {}
};
template <int MODE>
DI void run_gemm_round(const Ctx& c, int r, const bf16_t* A, const bf16_t* Bt, int Mr, int N, int K, bf16_t* O, int ldc, const bf16_t* G) {
    pg8::Gemm g{A, Bt, Mr, N, K};
    OneUnitOrder S; S.S.init(Mr, N, c.nb, c.bid); S.r = r;
    pg8::EpiT<MODE> E{O, ldc, G};
    pg8::gemm_phase<pg8::EpiT<MODE>, OneUnitOrder, true, true>((LAS unsigned char*)c.lds, g, S, E);
    __syncthreads();
}
template <int MODE>
DI void run_gemm(const Ctx& c, const bf16_t* A, const bf16_t* Bt, int Mr, int N, int K, bf16_t* O, int ldc, const bf16_t* G) {
    pg8::Gemm g{A, Bt, Mr, N, K};
    pg8::StaticOrder S; S.init(Mr, N, c.nb, c.bid);
    pg8::EpiT<MODE> E{O, ldc, G};
    pg8::gemm_phase<pg8::EpiT<MODE>, pg8::StaticOrder, true, true>((LAS unsigned char*)c.lds, g, S, E);
    __syncthreads();
#if (PROBE_MASK & 1)
    if (MODE != 3) { pg8::gemm_phase<pg8::EpiT<MODE>, pg8::StaticOrder, true, true>((LAS unsigned char*)c.lds, g, S, E); __syncthreads(); }
#endif
}

DI void run_gemm_ffn_up(const Ctx& c, int l, int r0, int rows) {
    pg8::Gemm g{(const bf16_t*)(c.pp->ws + WS_HX) + (size_t)r0 * D, wptr(c, l, OFF_WUP), rows, NUP, D};
    pg8::StaticOrder S; S.init(rows, NUP, c.nb, c.bid);
    pg8::EpiFfn E{(bf16_t*)(c.pp->ws + A_ACT), (bf16_t*)(c.pp->ws + A_ZUP), c.pp->in[29] + (size_t)l * 3 * NUP, c.pp->in[30] + l * NUP, (LAS float*)((LAS unsigned char*)c.lds + 131072)};
    pg8::gemm_phase<pg8::EpiFfn, pg8::StaticOrder, true, true>((LAS unsigned char*)c.lds, g, S, E);
    __syncthreads();
}
DI void phase_ffn_fix(const Ctx& c, int l, int r0, int nrows) {
    const bf16_t* EDGE = (const bf16_t*)(c.pp->ws + A_ZUP); bf16_t* ACT = (bf16_t*)(c.pp->ws + A_ACT);
    const float* cw = c.pp->in[29] + (size_t)l * 3 * NUP; const float* cb = c.pp->in[30] + l * NUP;
    const int ncg = DFF / 8, nunits = (nrows / 256) * 2 * ncg;
    for (int u = c.bid * NTHREADS + c.tid; u < nunits; u += c.nb * NTHREADS) {
        const int cgp = u % ncg, te = u / ncg, e = te & 1, tile = te >> 1, col = cgp * 8, tok = e ? 255 : 0;
        const int grow = r0 + tile * 256 + tok, seqmask = (grow < ML) ? (L - 1) : (LC - 1);
        const bool first = (grow & seqmask) == 0, last = (grow & seqmask) == seqmask;
        const bf16_t* rp = e ? EDGE + ((size_t)tile * 4 + 2) * NUP : EDGE + ((size_t)tile * 4 - 1) * NUP;
        u32x4 z[2][3];
#pragma unroll
        for (int pt = 0; pt < 2; ++pt)
#pragma unroll
            for (int i = 0; i < 3; ++i) {
                const bool ok = !((i == 0 && first) || (i == 2 && last));
                z[pt][i] = (u32x4){0u, 0u, 0u, 0u};
                if (ok) z[pt][i] = *(const u32x4*)(rp + (size_t)i * NUP + pt * DFF + col);
            }
        float ua[8], ub[8];
#pragma unroll
        for (int j = 0; j < 8; ++j) {
            float va[3], vb[3];
#pragma unroll
            for (int i = 0; i < 3; ++i) { va[i] = (j & 1) ? bf_hi(z[0][i][j >> 1]) : bf_lo(z[0][i][j >> 1]); vb[i] = (j & 1) ? bf_hi(z[1][i][j >> 1]) : bf_lo(z[1][i][j >> 1]); }
            ua[j] = va[0] * cw[col + j] + va[1] * cw[NUP + col + j] + va[2] * cw[2 * NUP + col + j] + cb[col + j];
            ub[j] = vb[0] * cw[DFF + col + j] + vb[1] * cw[NUP + DFF + col + j] + vb[2] * cw[2 * NUP + DFF + col + j] + cb[DFF + col + j];
        }
        u32x4 o;
        o.x = pk2(siluf_(ua[0]) * ub[0], siluf_(ua[1]) * ub[1]); o.y = pk2(siluf_(ua[2]) * ub[2], siluf_(ua[3]) * ub[3]);
        o.z = pk2(siluf_(ua[4]) * ub[4], siluf_(ua[5]) * ub[5]); o.w = pk2(siluf_(ua[6]) * ub[6], siluf_(ua[7]) * ub[7]);
        *(u32x4*)(ACT + (size_t)(tile * 256 + tok) * DFF + col) = o;
    }
}

DI void ffn_fix_tile(const Ctx& c, int l, int tile) {
    const bf16_t* EDGE = (const bf16_t*)(c.pp->ws + A_ZUP); bf16_t* ACT = (bf16_t*)(c.pp->ws + A_ACT);
    const float* cw = c.pp->in[29] + (size_t)l * 3 * NUP; const float* cb = c.pp->in[30] + l * NUP;
    const int ncg = DFF / 8;
    for (int u = c.tid; u < 2 * ncg; u += NTHREADS) {
        const int cgp = u % ncg, e = u / ncg, col = cgp * 8, tok = e ? 255 : 0;
        const int grow = tile * 256 + tok, seqmask = (grow < ML) ? (L - 1) : (LC - 1);
        const bool first = (grow & seqmask) == 0, last = (grow & seqmask) == seqmask;
        const bf16_t* rp = e ? EDGE + ((size_t)tile * 4 + 2) * NUP : EDGE + ((size_t)tile * 4 - 1) * NUP;
        u32x4 z[2][3];
#pragma unroll
        for (int pt = 0; pt < 2; ++pt)
#pragma unroll
            for (int i = 0; i < 3; ++i) {
                const bool ok = !((i == 0 && first) || (i == 2 && last));
                z[pt][i] = (u32x4){0u, 0u, 0u, 0u};
                if (ok) z[pt][i] = *(const u32x4*)(rp + (size_t)i * NUP + pt * DFF + col);
            }
        float ua[8], ub[8];
#pragma unroll
        for (int j = 0; j < 8; ++j) {
            float va[3], vb[3];
#pragma unroll
            for (int i = 0; i < 3; ++i) { va[i] = (j & 1) ? bf_hi(z[0][i][j >> 1]) : bf_lo(z[0][i][j >> 1]); vb[i] = (j & 1) ? bf_hi(z[1][i][j >> 1]) : bf_lo(z[1][i][j >> 1]); }
            ua[j] = va[0] * cw[col + j] + va[1] * cw[NUP + col + j] + va[2] * cw[2 * NUP + col + j] + cb[col + j];
            ub[j] = vb[0] * cw[DFF + col + j] + vb[1] * cw[NUP + DFF + col + j] + vb[2] * cw[2 * NUP + DFF + col + j] + cb[DFF + col + j];
        }
        u32x4 o;
        o.x = pk2(siluf_(ua[0]) * ub[0], siluf_(ua[1]) * ub[1]); o.y = pk2(siluf_(ua[2]) * ub[2], siluf_(ua[3]) * ub[3]);
        o.z = pk2(siluf_(ua[4]) * ub[4], siluf_(ua[5]) * ub[5]); o.w = pk2(siluf_(ua[6]) * ub[6], siluf_(ua[7]) * ub[7]);
        *(u32x4*)(ACT + (size_t)(tile * 256 + tok) * DFF + col) = o;
    }
}
DI void run_gemm_ffn_down(const Ctx& c, int l, int nrows) {
    pg8::StaticOrder S; S.init(nrows, D, c.nb, c.bid);
    pg8::Unit u;
#pragma unroll 1
    for (int i = 0; S.next(i, u); ++i) { const Ctx cl = relaunder(c); ffn_fix_tile(cl, l, u.pm); }
    asm volatile("s_waitcnt vmcnt(0)" ::: "memory");
    __syncthreads();
    run_gemm<0>(c, (const bf16_t*)(c.pp->ws + A_ACT), wptr(c, l, OFF_WDN), nrows, D, DFF, (bf16_t*)(c.pp->ws + WS_HX), D, nullptr);
}

DI void attn_prep_item(const Ctx& c, int l, int item) {
    const bf16_t* Z = (const bf16_t*)(c.pp->ws + P_R1);
    bf16_t* Q = (bf16_t*)(c.pp->ws + P_RQ); bf16_t* Kb = (bf16_t*)(c.pp->ws + P_RK); bf16_t* VT = (bf16_t*)(c.pp->ws + P_RV);
    const float* rope = (const float*)(c.pp->ws + WS_ROPE);
    const float* qn = c.pp->in[13] + l * 64; const float* kn = c.pp->in[14] + l * 64;
    bf16_t* vt_l = (bf16_t*)c.lds;
    const int row0 = item * 64, lane = c.lane;
    int b, p0; bool latent;
    if (row0 < ML) { b = row0 >> 11; p0 = 256 + (row0 & 2047); latent = true; } else { const int rc = row0 - ML; b = rc >> 8; p0 = rc & 255; latent = false; }
    u32x4 qraw[8]; unsigned kraw[8], vraw[8];
#pragma unroll
    for (int tk = 0; tk < 8; ++tk) {
        const bf16_t* zr = Z + (size_t)(row0 + c.wave * 8 + tk) * 2304;
        qraw[tk] = *(const u32x4*)(zr + (lane >> 3) * 64 + (lane & 7) * 8);
        kraw[tk] = *(const unsigned*)(zr + 512 + (lane >> 5) * 64 + (lane & 31) * 2);
        vraw[tk] = *(const unsigned*)(zr + 640 + (lane >> 5) * 64 + (lane & 31) * 2);
    }
#pragma unroll
    for (int tk = 0; tk < 8; ++tk) {
        const int ti = c.wave * 8 + tk, p = p0 + ti, t = p - 256;
        {
            const int hq = lane >> 3, d0 = (lane & 7) * 8;
            const u32x4 u = qraw[tk];
            float x[8] = {bf_lo(u.x), bf_hi(u.x), bf_lo(u.y), bf_hi(u.y), bf_lo(u.z), bf_hi(u.z), bf_lo(u.w), bf_hi(u.w)};
            float ss = 0.f;
#pragma unroll
            for (int j = 0; j < 8; ++j) ss += x[j] * x[j];
            ss += __shfl_xor(ss, 1); ss += __shfl_xor(ss, 2); ss += __shfl_xor(ss, 4);
            const float rs = rsqrtf(ss * (1.f / 64.f) + EPS);
#pragma unroll
            for (int j = 0; j < 8; ++j) x[j] = x[j] * rs * qn[d0 + j];
            if (latent) {
#pragma unroll
                for (int j = 0; j < 4; ++j) {
                    const int ip = (d0 >> 1) + j; const float2 cs = *(const float2*)(rope + ((size_t)t * 32 + ip) * 2);
                    const float x1 = x[2 * j], x2 = x[2 * j + 1];
                    x[2 * j] = x1 * cs.x - x2 * cs.y; x[2 * j + 1] = x1 * cs.y + x2 * cs.x;
                }
            }
            const float sc = 0.125f * 1.4426950408889634f;
            u32x4 o; o.x = pk2(x[0] * sc, x[1] * sc); o.y = pk2(x[2] * sc, x[3] * sc); o.z = pk2(x[4] * sc, x[5] * sc); o.w = pk2(x[6] * sc, x[7] * sc);
            *(u32x4*)(Q + (((size_t)(b * 8 + hq) * LT + p) * 64 + d0)) = o;
        }
        {
            const int kvh = lane >> 5, d0 = (lane & 31) * 2;
            const unsigned u = kraw[tk];
            float x1 = bf_lo(u), x2 = bf_hi(u);
            float ss = x1 * x1 + x2 * x2;
            ss += __shfl_xor(ss, 1); ss += __shfl_xor(ss, 2); ss += __shfl_xor(ss, 4); ss += __shfl_xor(ss, 8); ss += __shfl_xor(ss, 16);
            const float rs = rsqrtf(ss * (1.f / 64.f) + EPS);
            x1 = x1 * rs * kn[d0]; x2 = x2 * rs * kn[d0 + 1];
            if (latent) { const float2 cs = *(const float2*)(rope + ((size_t)t * 32 + (lane & 31)) * 2); const float a = x1 * cs.x - x2 * cs.y, bb = x1 * cs.y + x2 * cs.x; x1 = a; x2 = bb; }
            *(unsigned*)(Kb + (((size_t)(b * 2 + kvh) * LT + p) * 64 + d0)) = pk2(x1, x2);
            const unsigned uv = vraw[tk];
            vt_l[(kvh * 64 + d0) * 72 + ti] = (bf16_t)(uv & 0xffffu); vt_l[(kvh * 64 + d0 + 1) * 72 + ti] = (bf16_t)(uv >> 16);
        }
    }
    __syncthreads();
    {
        const int dd = c.tid >> 2, piece = c.tid & 3;
        const u32x4 a = *(const u32x4*)(vt_l + dd * 72 + piece * 16), bq = *(const u32x4*)(vt_l + dd * 72 + piece * 16 + 8);
        bf16_t* dst = VT + ((size_t)(b * 128 + dd) * LT + p0 + piece * 16);
        *(u32x4*)dst = a; *(u32x4*)(dst + 8) = bq;
    }
    __syncthreads();
}

DI void hy_prep_item(const Ctx& c, int l, int item) {
    const bf16_t* Z = (const bf16_t*)(c.pp->ws + P_R1);
    bf16_t* UF = (bf16_t*)(c.pp->ws + P_RU); bf16_t* X0C = (bf16_t*)(c.pp->ws + P_RX);
    const float* cw = c.pp->in[15] + (size_t)l * 3 * 1536; const float* cb = c.pp->in[16] + l * 1536;
    bf16_t* uf_l = (bf16_t*)c.lds;
    const int sg = item >> 3, cgp = item & 7, lane = c.lane;
    const int ch = cgp * 64 + (lane & 31) * 2, t0 = sg * 8;
    float w[3][3][2], bs[3][2];
#pragma unroll
    for (int pt = 0; pt < 3; ++pt) {
#pragma unroll
        for (int tp = 0; tp < 3; ++tp) { w[pt][tp][0] = cw[tp * 1536 + pt * 512 + ch]; w[pt][tp][1] = cw[tp * 1536 + pt * 512 + ch + 1]; }
        bs[pt][0] = cb[pt * 512 + ch]; bs[pt][1] = cb[pt * 512 + ch + 1];
    }
#pragma unroll
    for (int bi = 0; bi < 2; ++bi) {
        const int b = 2 * c.wave + (lane >> 5) + 16 * bi;
        const bf16_t* zb = Z + (size_t)(b * L) * 2304 + 768 + ch;
        unsigned zr[10][3];
#pragma unroll
        for (int i = 0; i < 10; ++i) {
            const int t = t0 - 1 + i; const bool ok = (t >= 0) && (t < L);
#pragma unroll
            for (int pt = 0; pt < 3; ++pt) { zr[i][pt] = 0u; if (ok) zr[i][pt] = *(const unsigned*)(zb + (size_t)t * 2304 + pt * 512); }
        }
#pragma unroll
        for (int s = 0; s < 8; ++s) {
            const int t = t0 + s;
            float zc[3][2];
#pragma unroll
            for (int pt = 0; pt < 3; ++pt) {
                zc[pt][0] = bf_lo(zr[s][pt]) * w[pt][0][0] + bf_lo(zr[s + 1][pt]) * w[pt][1][0] + bf_lo(zr[s + 2][pt]) * w[pt][2][0] + bs[pt][0];
                zc[pt][1] = bf_hi(zr[s][pt]) * w[pt][0][1] + bf_hi(zr[s + 1][pt]) * w[pt][1][1] + bf_hi(zr[s + 2][pt]) * w[pt][2][1] + bs[pt][1];
            }
            *(unsigned*)(X0C + (size_t)(b * L + t) * 512 + ch) = pk2(zc[0][0], zc[0][1]);
            const int cl = (lane & 31) * 2;
            uf_l[cl * 260 + b * 8 + s] = f2bf(zc[2][0] * zc[1][0]);
            uf_l[(cl + 1) * 260 + b * 8 + s] = f2bf(zc[2][1] * zc[1][1]);
        }
    }
    __syncthreads();
    const int J = sg >> 1, g = sg & 1;
#pragma unroll
    for (int i = 0; i < 4; ++i) {
        const int q = c.tid + NTHREADS * i, cl = q >> 5, b = q & 31;
        const u32x2 v0 = *(const u32x2*)(uf_l + cl * 260 + b * 8), v1 = *(const u32x2*)(uf_l + cl * 260 + b * 8 + 4);
        const u32x4 v = {v0.x, v0.y, v1.x, v1.y};
        *(u32x4*)(UF + ((((size_t)(cgp * 64 + cl) * 128 + J) * 64 + g * 32 + b) * 8)) = v;
    }
    __syncthreads();
}

DI void hy_ctx_item(const Ctx& c, int l, int item) {
    const bf16_t* Z = (const bf16_t*)(c.pp->ws + P_R1);
    bf16_t* CH = (bf16_t*)(c.pp->ws + WS_CH);
    const float* RC = (const float*)(c.pp->ws + WS_RC);
    const float* cw = c.pp->in[15] + (size_t)l * 3 * 1536; const float* cb = c.pp->in[16] + l * 1536;
    float* u_l = (float*)c.lds; float* x0_l = u_l + 256 * 64;
    const int b = item >> 3, cgp = item & 7;
    for (int i = c.tid; i < 256 * 64; i += NTHREADS) {
        const int t = i >> 6, cl = i & 63, ch = cgp * 64 + cl;
        const bf16_t* zb = Z + (size_t)(ML + b * LC) * 2304 + 768 + ch;
        float zc[3];
#pragma unroll
        for (int pt = 0; pt < 3; ++pt) {
            const float a0 = t > 0 ? bf2f(zb[(size_t)(t - 1) * 2304 + pt * 512]) : 0.f, a1 = bf2f(zb[(size_t)t * 2304 + pt * 512]), a2 = t + 1 < LC ? bf2f(zb[(size_t)(t + 1) * 2304 + pt * 512]) : 0.f;
            zc[pt] = a0 * cw[pt * 512 + ch] + a1 * cw[1536 + pt * 512 + ch] + a2 * cw[3072 + pt * 512 + ch] + cb[pt * 512 + ch];
        }
        u_l[t * 64 + cl] = zc[2] * zc[1]; x0_l[t * 64 + cl] = zc[0];
    }
    __syncthreads();
    const int cl = c.tid & 63, t0 = (c.tid >> 6) * 32, ch = cgp * 64 + cl;
    const float* gc = RC + (size_t)ch * 512;
    float acc[32];
#pragma unroll
    for (int i = 0; i < 32; ++i) acc[i] = 0.f;
    for (int s0 = 0; s0 < 256; s0 += 32) {
        float wv[63];
        const int base = t0 - s0 + 256;
#pragma unroll
        for (int k = 0; k < 63; ++k) wv[k] = gc[base - 31 + k];
#pragma unroll
        for (int j = 0; j < 32; ++j) {
            const float uu = u_l[(s0 + j) * 64 + cl];
#pragma unroll
            for (int i = 0; i < 32; ++i) acc[i] += wv[31 + i - j] * uu;
        }
    }
#pragma unroll
    for (int i = 0; i < 32; ++i) CH[(size_t)(b * LC + t0 + i) * 512 + ch] = f2bf(acc[i] * x0_l[(t0 + i) * 64 + cl]);
    __syncthreads();
}

DI void phase_prep(const Ctx& c0, int l) {
    const int n_attn = M / 64, n_hy = 2048, n_ctx = (l == 0) ? 256 : 0;
    const int total = n_ctx + n_attn + n_hy;
    for (int it = c0.bid; it < total; it += c0.nb) {
        const Ctx c = relaunder(c0);
        if (it < n_ctx) hy_ctx_item(c, l, it);
        else if (it < n_ctx + n_attn) attn_prep_item(c, l, it - n_ctx);
        else hy_prep_item(c, l, it - n_ctx - n_attn);
    }
}

DI void attn_item(const Ctx& c, int b, int kvh, int qb) {
    const bf16_t* Q = (const bf16_t*)(c.pp->ws + P_RQ); const bf16_t* Kb = (const bf16_t*)(c.pp->ws + P_RK); const bf16_t* VT = (const bf16_t*)(c.pp->ws + P_RV);
    bf16_t* Bo = (bf16_t*)(c.pp->ws + P_RB);
    constexpr int AT_K = 0, AT_V = 128 * 144, AT_BUF = 128 * 144 + 64 * 264;
    LAS unsigned char* lbase = (LAS unsigned char*)c.lds;
    const int lane = c.lane, r32 = lane & 31, h = lane >> 5, hq = kvh * 4 + (c.wave & 3), qs = c.wave >> 2;
    const int p0 = qb * 64, qrow = p0 + qs * 32 + r32, ntile = (qb < 4) ? 2 : 18;
    bf16x8 qf[4];
    { const bf16_t* qp = Q + (((size_t)(b * 8 + hq) * LT + qrow) * 64) + 8 * h;
#pragma unroll
      for (int s = 0; s < 4; ++s) qf[s] = *(const bf16x8*)(qp + 16 * s); }
    const bf16_t* kg = Kb + (size_t)(b * 2 + kvh) * LT * 64 + c.tid * 8;
    const bf16_t* vg = VT + ((size_t)(b * 2 + kvh) * 64 + (c.tid >> 3)) * LT + (c.tid & 7) * 8;
    const int kst = (c.tid >> 3) * 144 + (c.tid & 7) * 16, vst = (c.tid >> 3) * 264 + (c.tid & 7) * 16;
    u32x4 kreg0 = *(const u32x4*)kg, kreg1 = *(const u32x4*)(kg + 4096), vreg0 = *(const u32x4*)vg, vreg1 = *(const u32x4*)(vg + 64);
    f32x16 o0, o1, o2, negm;
#pragma unroll
    for (int i = 0; i < 16; ++i) { o0[i] = 0.f; o1[i] = 0.f; o2[i] = 0.f; negm[i] = 0.f; }
    const bf16x8 ones = __builtin_bit_cast(bf16x8, (u32x4){0x3F803F80u, 0x3F803F80u, 0x3F803F80u, 0x3F803F80u});
    const float THR = 6.f;
    lds_barrier();
    *(LAS u32x4*)(lbase + AT_K + kst) = kreg0; *(LAS u32x4*)(lbase + AT_K + 64 * 144 + kst) = kreg1;
    *(LAS u32x2*)(lbase + AT_V + vst) = (u32x2){vreg0.x, vreg0.y}; *(LAS u32x2*)(lbase + AT_V + vst + 8) = (u32x2){vreg0.z, vreg0.w}; *(LAS u32x2*)(lbase + AT_V + vst + 128) = (u32x2){vreg1.x, vreg1.y}; *(LAS u32x2*)(lbase + AT_V + vst + 128 + 8) = (u32x2){vreg1.z, vreg1.w};
    if (ntile > 1) { kreg0 = *(const u32x4*)(kg + 8192); kreg1 = *(const u32x4*)(kg + 8192 + 4096); vreg0 = *(const u32x4*)(vg + 128); vreg1 = *(const u32x4*)(vg + 128 + 64); }
    lds_barrier();
    const bool late = c.wave >= 4;
    int slot = 0;
    for (int tile = 0; tile < ntile; ++tile) {
        LAS unsigned char* cur = lbase + slot * AT_BUF;
        slot = (slot == 2) ? 0 : slot + 1;
        if (tile + 1 < ntile) {
            LAS unsigned char* nxt = lbase + slot * AT_BUF;
            *(LAS u32x4*)(nxt + AT_K + kst) = kreg0; *(LAS u32x4*)(nxt + AT_K + 64 * 144 + kst) = kreg1;
            *(LAS u32x2*)(nxt + AT_V + vst) = (u32x2){vreg0.x, vreg0.y}; *(LAS u32x2*)(nxt + AT_V + vst + 8) = (u32x2){vreg0.z, vreg0.w}; *(LAS u32x2*)(nxt + AT_V + vst + 128) = (u32x2){vreg1.x, vreg1.y}; *(LAS u32x2*)(nxt + AT_V + vst + 128 + 8) = (u32x2){vreg1.z, vreg1.w};
            if (tile + 2 < ntile) {
                const bf16_t* k2 = kg + (size_t)(tile + 2) * 8192; const bf16_t* v2 = vg + (tile + 2) * 128;
                kreg0 = *(const u32x4*)k2; kreg1 = *(const u32x4*)(k2 + 4096); vreg0 = *(const u32x4*)v2; vreg1 = *(const u32x4*)(v2 + 64);
            }
        }
        bf16x8 kf[16];
#pragma unroll
        for (int s = 0; s < 4; ++s)
#pragma unroll
            for (int q4 = 0; q4 < 4; ++q4) kf[4 * s + q4] = *(const LAS bf16x8*)(cur + AT_K + (32 * q4 + r32) * 144 + (16 * s + 8 * h) * 2);
        __builtin_amdgcn_sched_barrier(0);
        f32x16 sa0 = negm, sa1 = negm, sb0 = negm, sb1 = negm;
#pragma unroll
        for (int s = 0; s < 4; ++s) {
            sa0 = __builtin_amdgcn_mfma_f32_32x32x16_bf16(kf[4 * s + 0], qf[s], sa0, 0, 0, 0);
            sa1 = __builtin_amdgcn_mfma_f32_32x32x16_bf16(kf[4 * s + 1], qf[s], sa1, 0, 0, 0);
        }
#pragma unroll
        for (int s = 0; s < 4; ++s) {
            sb0 = __builtin_amdgcn_mfma_f32_32x32x16_bf16(kf[4 * s + 2], qf[s], sb0, 0, 0, 0);
            sb1 = __builtin_amdgcn_mfma_f32_32x32x16_bf16(kf[4 * s + 3], qf[s], sb1, 0, 0, 0);
        }
        __builtin_amdgcn_sched_barrier(0);
#pragma unroll
        for (int hf = 0; hf < 2; ++hf) {
            const LAS unsigned char* vt = cur + AT_V + hf * 128;
            u32x2 vfr[4][4];
#pragma unroll
            for (int f = 0; f < 4; ++f) {
                const int koff = (16 * f + 4 * h) * 2;
                vfr[f][0] = *(const LAS u32x2*)(vt + r32 * 264 + koff); vfr[f][1] = *(const LAS u32x2*)(vt + r32 * 264 + koff + 16);
                vfr[f][2] = *(const LAS u32x2*)(vt + (32 + r32) * 264 + koff); vfr[f][3] = *(const LAS u32x2*)(vt + (32 + r32) * 264 + koff + 16);
            }
            __builtin_amdgcn_sched_barrier(0);
            f32x16& s0 = hf ? sb0 : sa0; f32x16& s1 = hf ? sb1 : sa1;
            float mt = fmaxf(fmaxf(s0[0], s0[1]), s0[2]);
#pragma unroll
            for (int i = 3; i < 15; i += 2) mt = fmaxf(fmaxf(mt, s0[i]), s0[i + 1]);
            mt = fmaxf(fmaxf(mt, s0[15]), s1[0]);
#pragma unroll
            for (int i = 1; i < 15; i += 2) mt = fmaxf(fmaxf(mt, s1[i]), s1[i + 1]);
            mt = fmaxf(mt, s1[15]);
            mt = fmaxf(mt, __shfl_xor(mt, 32));
            if (__builtin_amdgcn_ballot_w64(mt > THR) != 0ull) {
                const float delta = mt > THR ? mt : 0.f, alpha = __builtin_amdgcn_exp2f(-delta);
#pragma unroll
                for (int i = 0; i < 16; ++i) { negm[i] -= delta; s0[i] -= delta; s1[i] -= delta; o0[i] *= alpha; o1[i] *= alpha; o2[i] *= alpha; }
                if (hf == 0) {
#pragma unroll
                    for (int i = 0; i < 16; ++i) { sb0[i] -= delta; sb1[i] -= delta; }
                }
            }
#pragma unroll
            for (int i = 0; i < 16; ++i) { s0[i] = __builtin_amdgcn_exp2f(s0[i]); s1[i] = __builtin_amdgcn_exp2f(s1[i]); }
            bf16x8 pf[4];
#pragma unroll
            for (int s2 = 0; s2 < 2; ++s2) {
                pf[s2] = __builtin_bit_cast(bf16x8, (u32x4){pk2(s0[8 * s2], s0[8 * s2 + 1]), pk2(s0[8 * s2 + 2], s0[8 * s2 + 3]), pk2(s0[8 * s2 + 4], s0[8 * s2 + 5]), pk2(s0[8 * s2 + 6], s0[8 * s2 + 7])});
                pf[2 + s2] = __builtin_bit_cast(bf16x8, (u32x4){pk2(s1[8 * s2], s1[8 * s2 + 1]), pk2(s1[8 * s2 + 2], s1[8 * s2 + 3]), pk2(s1[8 * s2 + 4], s1[8 * s2 + 5]), pk2(s1[8 * s2 + 6], s1[8 * s2 + 7])});
            }
            __builtin_amdgcn_sched_barrier(0);
            if (hf == 1 && late) lds_barrier();
#pragma unroll
            for (int f = 0; f < 4; ++f) {
                const bf16x8 va = __builtin_bit_cast(bf16x8, (u32x4){vfr[f][0].x, vfr[f][0].y, vfr[f][1].x, vfr[f][1].y});
                const bf16x8 vb = __builtin_bit_cast(bf16x8, (u32x4){vfr[f][2].x, vfr[f][2].y, vfr[f][3].x, vfr[f][3].y});
                o0 = __builtin_amdgcn_mfma_f32_32x32x16_bf16(va, pf[f], o0, 0, 0, 0);
                o1 = __builtin_amdgcn_mfma_f32_32x32x16_bf16(vb, pf[f], o1, 0, 0, 0);
                o2 = __builtin_amdgcn_mfma_f32_32x32x16_bf16(ones, pf[f], o2, 0, 0, 0);
            }
            __builtin_amdgcn_sched_barrier(0);
        }
        if (!late) lds_barrier();
    }
    const float inv = 1.f / o2[0];
    const int orow = (qrow < 256) ? (ML + b * LC + qrow) : (b * L + qrow - 256);
    bf16_t* op = Bo + (size_t)orow * 512 + hq * 64;
#pragma unroll
    for (int g4 = 0; g4 < 4; ++g4) {
        u32x2 w0, w1;
        w0.x = pk2(o0[4 * g4] * inv, o0[4 * g4 + 1] * inv); w0.y = pk2(o0[4 * g4 + 2] * inv, o0[4 * g4 + 3] * inv);
        w1.x = pk2(o1[4 * g4] * inv, o1[4 * g4 + 1] * inv); w1.y = pk2(o1[4 * g4 + 2] * inv, o1[4 * g4 + 3] * inv);
        *(u32x2*)(op + 8 * g4 + 4 * h) = w0; *(u32x2*)(op + 32 + 8 * g4 + 4 * h) = w1;
    }
}

constexpr int HY_CS = 8224;
DI void hy_conv_item(const Ctx& c, int l, int ch) {
    const bf16_t* R = (const bf16_t*)(c.pp->ws + WS_RL) + ((size_t)l * 512 + ch) * 4096;
    const bf16_t* UF = (const bf16_t*)(c.pp->ws + P_RU) + (size_t)ch * 128 * 512;
    bf16_t* YT = (bf16_t*)(c.pp->ws + P_RY) + (size_t)ch * 2048 * 32;
    __syncthreads();
    for (int i = c.tid; i < 8 * 4096; i += NTHREADS) {
        const int r = i >> 12, m = i & 4095, src = m + r;
        *(LAS bf16_t*)((LAS unsigned char*)c.lds + r * HY_CS + m * 2) = (src < 4096) ? R[src] : (bf16_t)0;
    }
    __syncthreads();
    const int lane = c.lane, ir = lane & 31, g = lane >> 5;
    const int nb0 = 2048 - ir + 8 * g;
    const int rr = nb0 & 7, qq = nb0 >> 3;
    const LAS unsigned char* abase = (const LAS unsigned char*)c.lds + rr * HY_CS + qq * 16;
    f32x16 acc[8];
#pragma unroll
    for (int i = 0; i < 8; ++i)
#pragma unroll
        for (int j = 0; j < 16; ++j) acc[i][j] = 0.f;
    const int I0 = c.wave * 8;
    bf16x8 a0[8], a1[8];
#pragma unroll
    for (int i = 0; i < 8; ++i) { a0[i] = *(const LAS bf16x8*)(abase + (0 - 4 * (I0 + i)) * 16); a1[i] = *(const LAS bf16x8*)(abase + (2 - 4 * (I0 + i)) * 16); }
    bf16x8 bcur = *(const bf16x8*)(UF + (size_t)lane * 8);
    for (int jb = 0; jb < 64; jb += 8) {
#pragma unroll
        for (int jj = 0; jj < 8; ++jj) {
#pragma unroll
            for (int p = 0; p < 2; ++p) {
                const int J = 2 * (jb + jj) + p;
                const int Jn = (J + 1 < 128) ? J + 1 : J, J2 = (J + 2 < 128) ? J + 2 : J;
                const bf16x8 bnext = *(const bf16x8*)(UF + ((size_t)Jn * 64 + lane) * 8);
                const bf16x8 fnew = *(const LAS bf16x8*)(abase + (2 * J2 - 4 * I0) * 16);
#pragma unroll
                for (int i = 0; i < 8; ++i) acc[i] = __builtin_amdgcn_mfma_f32_32x32x16_bf16(p ? a1[(i - jj) & 7] : a0[(i - jj) & 7], bcur, acc[i], 0, 0, 0);
                if (p) a1[(7 - jj) & 7] = fnew; else a0[(7 - jj) & 7] = fnew;
                bcur = bnext;
            }
        }
    }
    int irl = ir; asm volatile("" : "+v"(irl));
    bf16_t* yb = YT + (size_t)(I0 * 32 + 4 * g) * 32 + irl;
#pragma unroll
    for (int i = 0; i < 8; ++i)
#pragma unroll
        for (int rg = 0; rg < 16; ++rg) yb[(i * 32 + (rg & 3) + 8 * (rg >> 2)) * 32] = f2bf(acc[i][rg]);
}

DI void hy_final_item(const Ctx& c, int item) {
    const bf16_t* YT = (const bf16_t*)(c.pp->ws + P_RY); const bf16_t* X0C = (const bf16_t*)(c.pp->ws + P_RX);
    bf16_t* Co = (bf16_t*)(c.pp->ws + P_RQ);
    bf16_t* y_l = (bf16_t*)c.lds;
    const int sg = item >> 3, cgp = item & 7, t0 = sg * 8;
#pragma unroll
    for (int i = 0; i < 4; ++i) {
        const int q = c.tid + NTHREADS * i, cl = q >> 5, piece = q & 31;
        const u32x4 v = *(const u32x4*)(YT + ((size_t)(cgp * 64 + cl) * 2048 + t0) * 32 + piece * 8);
        *(u32x4*)(y_l + cl * 264 + piece * 8) = v;
    }
    __syncthreads();
#pragma unroll
    for (int k = 0; k < 16; ++k) {
        const int idx = c.tid + NTHREADS * k, chp = idx & 31, bt = idx >> 5, t = bt & 7, b = bt >> 3;
        const float y0 = bf2f(y_l[(2 * chp) * 264 + t * 32 + b]), y1 = bf2f(y_l[(2 * chp + 1) * 264 + t * 32 + b]);
        const size_t off = (size_t)(b * L + t0 + t) * 512 + cgp * 64 + 2 * chp;
        const unsigned xv = *(const unsigned*)(X0C + off);
        *(unsigned*)(Co + off) = pk2(y0 * bf_lo(xv), y1 * bf_hi(xv));
    }
    __syncthreads();
}

DI void phase_hyfinal(const Ctx& c, int l) {
    for (int it = c.bid; it < 2048; it += c.nb) hy_final_item(c, it);
    if (l == 0) {
        const u32x4* src = (const u32x4*)(c.pp->ws + WS_CH); u32x4* dst = (u32x4*)((bf16_t*)(c.pp->ws + P_RQ) + (size_t)ML * 512);
        for (int i = c.bid * NTHREADS + c.tid; i < MC * 512 / 8; i += c.nb * NTHREADS) dst[i] = src[i];
    }
}

DI int scan_row(int b, int dir, int n) {
    if (n < LC) return ML + b * LC + (dir ? (LC - 1 - n) : n);
    const int t = n - LC; return b * L + (dir ? (L - 1 - t) : t);
}
constexpr int SC_ROW = 96;
constexpr int SC_QD = 0, SC_KG = 8704, SC_KDT = 17408, SC_VT = SC_KDT + 128 * SC_ROW, SC_EG = SC_VT + 128 * SC_ROW, SC_AM = SC_EG + 512, SC_SET = SC_AM + 32 * SC_ROW;
DI void scan_item_mfma(const Ctx& c, int l, int item) {
    const bf16_t* Z = (const bf16_t*)(c.pp->ws + P_R1);
    const int b = item >> 3, hh = (item >> 1) & 3, dir = item & 1;
    bf16_t* Oo = (bf16_t*)(c.pp->ws + (dir ? A_OB : A_OF));
    LAS unsigned char* lds = (LAS unsigned char*)c.lds;
    const int tid = c.tid, lane = c.lane, w = c.wave, r16 = lane & 15, g = lane >> 4;
    const int kp = tid >> 3, tq = tid & 7;
    float lb[2] = {0.f, 0.f};
    if (l == 1) {
#pragma unroll
        for (int e = 0; e < 2; ++e) { const int k = hh * 128 + 2 * kp + e; const float x0 = c.pp->in[11][(0 * 2 + dir) * 512 + k], x1 = c.pp->in[11][(1 * 2 + dir) * 512 + k]; lb[e] = 1.f / (1.f + expf(x0 - x1)); }
    }
    __syncthreads();
    if (tid < 256) { const int set = tid >> 7, q = tid & 127, row = q >> 3, dw = q & 7; *(LAS unsigned*)(lds + set * SC_SET + SC_AM + row * SC_ROW + 32 + dw * 4) = 0u; }
    f32x4 S[8]; u32x2 Sb[8];
#pragma unroll
    for (int i = 0; i < 8; ++i) { S[i] = (f32x4){0.f, 0.f, 0.f, 0.f}; Sb[i] = (u32x2){0u, 0u}; }
    unsigned raw[12];
    const size_t colq = (size_t)hh * 128 + 2 * kp;
    const int rstep = dir ? -1 : 1;
    {
        const bf16_t* base = Z + (size_t)scan_row(b, dir, 4 * tq) * 2560 + colq;
#pragma unroll
        for (int j = 0; j < 4; ++j) {
            const bf16_t* bj = base + (ptrdiff_t)(j * rstep) * 2560;
            raw[3 * j] = *(const unsigned*)bj; raw[3 * j + 1] = *(const unsigned*)(bj + 512 + dir * 512); raw[3 * j + 2] = *(const unsigned*)(bj + 1536);
        }
    }
    const float L2E = 1.4426950408889634f;
    for (int n = 0; n < LT / 32; ++n) {
        LAS unsigned char* ls = lds + (n & 1) * SC_SET;
        {
            float lf[4][2], kk[4][2];
#pragma unroll
            for (int j = 0; j < 4; ++j)
#pragma unroll
                for (int e = 0; e < 2; ++e) {
                    const float z = e ? bf_hi(raw[3 * j + 1]) : bf_lo(raw[3 * j + 1]);
                    const float sg = __builtin_amdgcn_rcpf(1.f + __builtin_amdgcn_exp2f(-z * L2E));
                    const float f = lb[e] + (1.f - lb[e]) * sg;
                    lf[j][e] = __builtin_amdgcn_logf(f); kk[j][e] = 1.f - f;
                }
            float cs[4][2], incl[2], excl[2], glast[2];
#pragma unroll
            for (int e = 0; e < 2; ++e) {
                cs[0][e] = lf[0][e]; cs[1][e] = cs[0][e] + lf[1][e]; cs[2][e] = cs[1][e] + lf[2][e]; cs[3][e] = cs[2][e] + lf[3][e];
                float x = cs[3][e];
#pragma unroll
                for (int d = 1; d < 8; d <<= 1) { const float y = __shfl_up(x, d, 8); if (tq >= d) x += y; }
                incl[e] = x; excl[e] = x - cs[3][e]; glast[e] = __shfl(x, 7, 8);
            }
            float egl[2] = {__builtin_amdgcn_exp2f(glast[0]), __builtin_amdgcn_exp2f(glast[1])};
            float kd[4][2];
#pragma unroll
            for (int j = 0; j < 4; ++j) {
                const int t = 4 * tq + j;
                float qd[2], kg[2];
#pragma unroll
                for (int e = 0; e < 2; ++e) {
                    const float G = excl[e] + cs[j][e];
                    const float q = e ? bf_hi(raw[3 * j]) : bf_lo(raw[3 * j]);
                    qd[e] = q * __builtin_amdgcn_exp2f(G);
                    kg[e] = kk[j][e] * __builtin_amdgcn_exp2f(fminf(-G, 115.f));
                    kd[j][e] = kg[e] * egl[e];
                }
                *(LAS unsigned*)(ls + SC_QD + t * 272 + kp * 4) = pk2(qd[0], qd[1]);
                *(LAS unsigned*)(ls + SC_KG + t * 272 + kp * 4) = pk2(kg[0], kg[1]);
            }
#pragma unroll
            for (int e = 0; e < 2; ++e) {
                u32x2 kw; kw.x = pk2(kd[0][e], kd[1][e]); kw.y = pk2(kd[2][e], kd[3][e]);
                *(LAS u32x2*)(ls + SC_KDT + (2 * kp + e) * SC_ROW + tq * 8) = kw;
                u32x2 vw;
                if (e == 0) { vw.x = (raw[2] & 0xffffu) | (raw[5] << 16); vw.y = (raw[8] & 0xffffu) | (raw[11] << 16); }
                else { vw.x = (raw[2] >> 16) | (raw[5] & 0xffff0000u); vw.y = (raw[8] >> 16) | (raw[11] & 0xffff0000u); }
                *(LAS u32x2*)(ls + SC_VT + (2 * kp + e) * SC_ROW + tq * 8) = vw;
            }
            if (tq == 7) *(LAS f32x2*)(ls + SC_EG + kp * 8) = (f32x2){egl[0], egl[1]};
        }
        lds_barrier();
        if (n + 1 < LT / 32) {
            const bf16_t* base = Z + (size_t)scan_row(b, dir, (n + 1) * 32 + 4 * tq) * 2560 + colq;
#pragma unroll
            for (int j = 0; j < 4; ++j) {
                const bf16_t* bj = base + (ptrdiff_t)(j * rstep) * 2560;
                raw[3 * j] = *(const unsigned*)bj; raw[3 * j + 1] = *(const unsigned*)(bj + 512 + dir * 512); raw[3 * j + 2] = *(const unsigned*)(bj + 1536);
            }
        }
        if (w < 3) {
            const int tt = (w + 1) >> 1, st = (w == 2) ? 1 : 0;
            f32x4 a = {0.f, 0.f, 0.f, 0.f};
#pragma unroll
            for (int ks = 0; ks < 4; ++ks) {
                const bf16x8 qa = *(const LAS bf16x8*)(ls + SC_QD + (16 * tt + r16) * 272 + (32 * ks + 8 * g) * 2);
                const bf16x8 kb = *(const LAS bf16x8*)(ls + SC_KG + (16 * st + r16) * 272 + (32 * ks + 8 * g) * 2);
                a = __builtin_amdgcn_mfma_f32_16x16x32_bf16(qa, kb, a, 0, 0, 0);
            }
#pragma unroll
            for (int r = 0; r < 4; ++r) {
                const int tg = 16 * tt + 4 * g + r, sg = 16 * st + r16;
                *(LAS bf16_t*)(ls + SC_AM + tg * SC_ROW + sg * 2) = f2bf(sg <= tg ? a[r] : 0.f);
            }
        }
        f32x4 o[2] = {(f32x4){0.f, 0.f, 0.f, 0.f}, (f32x4){0.f, 0.f, 0.f, 0.f}};
        {
            u32x2 qa0[4][2], qa1[4][2];
#pragma unroll
            for (int ks = 0; ks < 4; ++ks)
#pragma unroll
                for (int tt = 0; tt < 2; ++tt) {
                    qa0[ks][tt] = *(const LAS u32x2*)(ls + SC_QD + (16 * tt + r16) * 272 + (32 * ks + 4 * g) * 2);
                    qa1[ks][tt] = *(const LAS u32x2*)(ls + SC_QD + (16 * tt + r16) * 272 + (32 * ks + 16 + 4 * g) * 2);
                }
            __builtin_amdgcn_sched_barrier(0);
#pragma unroll
            for (int ks = 0; ks < 4; ++ks) {
                const bf16x8 sb = __builtin_bit_cast(bf16x8, (u32x4){Sb[2 * ks].x, Sb[2 * ks].y, Sb[2 * ks + 1].x, Sb[2 * ks + 1].y});
#pragma unroll
                for (int tt = 0; tt < 2; ++tt) {
                    const bf16x8 qa = __builtin_bit_cast(bf16x8, (u32x4){qa0[ks][tt].x, qa0[ks][tt].y, qa1[ks][tt].x, qa1[ks][tt].y});
                    o[tt] = __builtin_amdgcn_mfma_f32_16x16x32_bf16(qa, sb, o[tt], 0, 0, 0);
                }
            }
        }
        lds_barrier();
        const bf16x8 vb = *(const LAS bf16x8*)(ls + SC_VT + (16 * w + r16) * SC_ROW + g * 16);
#pragma unroll
        for (int tt = 0; tt < 2; ++tt) {
            const bf16x8 am = *(const LAS bf16x8*)(ls + SC_AM + (16 * tt + r16) * SC_ROW + g * 16);
            o[tt] = __builtin_amdgcn_mfma_f32_16x16x32_bf16(am, vb, o[tt], 0, 0, 0);
        }
        {
            bf16_t* ob = Oo + (size_t)scan_row(b, dir, n * 32 + 4 * g) * 512 + hh * 128 + 16 * w + r16;
#pragma unroll
            for (int tt = 0; tt < 2; ++tt)
#pragma unroll
                for (int r = 0; r < 4; ++r) ob[(ptrdiff_t)((16 * tt + r) * rstep) * 512] = f2bf(o[tt][r]);
        }
        {
            f32x4 dec[8]; bf16x8 ka[8];
#pragma unroll
            for (int kt = 0; kt < 8; ++kt) { dec[kt] = *(const LAS f32x4*)(ls + SC_EG + (16 * kt + 4 * g) * 4); ka[kt] = *(const LAS bf16x8*)(ls + SC_KDT + (16 * kt + r16) * SC_ROW + g * 16); }
            __builtin_amdgcn_sched_barrier(0);
#pragma unroll
            for (int kt = 0; kt < 8; ++kt) S[kt] = __builtin_amdgcn_mfma_f32_16x16x32_bf16(ka[kt], vb, S[kt] * dec[kt], 0, 0, 0);
#pragma unroll
            for (int kt = 0; kt < 8; ++kt) { Sb[kt].x = pk2(S[kt][0], S[kt][1]); Sb[kt].y = pk2(S[kt][2], S[kt][3]); }
        }
    }
    __syncthreads();
}

DI void phase_combine(const Ctx& c, int l, int nrows) {
    const bf16_t* Z = (const bf16_t*)(c.pp->ws + P_R1);
    bf16_t* OF = (bf16_t*)(c.pp->ws + A_OF); const bf16_t* OB = (const bf16_t*)(c.pp->ws + A_OB);
    const float* gn = c.pp->in[12] + l * 128;
    const int d0 = (c.lane & 15) * 8;
    float gnv[8];
#pragma unroll
    for (int j = 0; j < 8; ++j) gnv[j] = gn[d0 + j];
    const int rpw = ((nrows + c.nb * 8 * RPW - 1) / (c.nb * 8 * RPW)) * RPW;
    for (int rbase = (c.bid * 8 + c.wave) * rpw; rbase < (c.bid * 8 + c.wave + 1) * rpw && rbase < nrows; rbase += RPW) {
        u32x4 uf[RPW], ub[RPW], ug[RPW];
#pragma unroll
        for (int r = 0; r < RPW; ++r) {
            const size_t off = (size_t)(rbase + r) * 512 + c.lane * 8;
            uf[r] = *(const u32x4*)(OF + off); ub[r] = *(const u32x4*)(OB + off); ug[r] = *(const u32x4*)(Z + (size_t)(rbase + r) * 2560 + 2048 + c.lane * 8);
        }
#pragma unroll
        for (int r = 0; r < RPW; ++r) {
            float s[8], gt[8];
#pragma unroll
            for (int q = 0; q < 4; ++q) { s[2 * q] = bf_lo(uf[r][q]) + bf_lo(ub[r][q]); s[2 * q + 1] = bf_hi(uf[r][q]) + bf_hi(ub[r][q]); gt[2 * q] = bf_lo(ug[r][q]); gt[2 * q + 1] = bf_hi(ug[r][q]); }
            float ss = 0.f;
#pragma unroll
            for (int j = 0; j < 8; ++j) ss += s[j] * s[j];
            ss += __shfl_xor(ss, 1); ss += __shfl_xor(ss, 2); ss += __shfl_xor(ss, 4); ss += __shfl_xor(ss, 8);
            const float rs = rsqrtf(ss * (1.f / 128.f) + EPS);
#pragma unroll
            for (int j = 0; j < 8; ++j) s[j] = s[j] * rs * gnv[j] * siluf_(gt[j]);
            u32x4 o; o.x = pk2(s[0], s[1]); o.y = pk2(s[2], s[3]); o.z = pk2(s[4], s[5]); o.w = pk2(s[6], s[7]);
            *(u32x4*)(OF + (size_t)(rbase + r) * 512 + c.lane * 8) = o;
        }
    }
}

constexpr int NPL = 12;
constexpr int NPHASES = 2 + 2 * NPL;

DI void run_phase(const Ctx& c0, int ph) {
    Ctx c = c0;
    asm volatile("" : "+v"(c.tid)); asm volatile("" : "+s"(c.bid));
    { auto kp = __builtin_amdgcn_kernarg_segment_ptr(); asm volatile("" : "+s"(kp)); c.pp = (ParamsPtr)kp; }
    c.lane = c.tid & 63; c.wave = __builtin_amdgcn_readfirstlane(c.tid >> 6);
    unsigned char* ws = c.pp->ws;
    bf16_t* HX = (bf16_t*)(ws + WS_HX);
    if (ph == 0) { for (int rep = 0; rep < ((PROBE_MASK & 32) ? 2 : 1); ++rep) phase_prologue(c); return; }
    if (ph == 1) { for (int rep = 0; rep < ((PROBE_MASK & 64) ? 2 : 1); ++rep) phase_mod0(c); return; }
    const int l = (ph - 2) / NPL, q = (ph - 2) % NPL;
    const int nrows = (l == 0) ? M : ML;
    switch (q) {
    case 0:
        if (l == 0) run_gemm<0>(c, HX, wptr(c, l, OFF_WIN) + (size_t)2560 * D, M, 2304, D, (bf16_t*)(ws + P_R1), 2304, nullptr);
        else {
            run_gemm<0>(c, HX, wptr(c, l, OFF_WIN) + (size_t)2560 * D, ML, 2304, D, (bf16_t*)(ws + P_R1), 2304, nullptr);
            run_gemm<0>(c, HX + (size_t)ML * D, wptr(c, l, OFF_WIN) + (size_t)(2560 + 512) * D, MC, 256, D, (bf16_t*)(ws + P_R1) + (size_t)ML * 2304 + 512, 2304, nullptr);
        }
        break;
    case 1: for (int rep = 0; rep < ((PROBE_MASK & 16) ? 2 : 1); ++rep) phase_prep(c, l); break;
    case 2: {
        if (l == 0) run_gemm<0>(c, HX, wptr(c, l, OFF_WIN), M, 2560, D, (bf16_t*)(ws + P_R1), 2560, nullptr);
        else {
            run_gemm<0>(c, HX, wptr(c, l, OFF_WIN), ML, 2560, D, (bf16_t*)(ws + P_R1), 2560, nullptr);
            run_gemm<0>(c, HX + (size_t)ML * D, wptr(c, l, OFF_WIN) + (size_t)512 * D, MC, 1536, D, (bf16_t*)(ws + P_R1) + (size_t)ML * 2560 + 512, 2560, nullptr);
        }
        {
            const int nqb = (l == 0) ? 36 : 32, nitems = NB * 2 * nqb;
            const bool loc = (c.nb == 256);
            const int nr = loc ? ((l == 0) ? 9 : 8) : (nitems + c.nb - 1) / c.nb;
#pragma unroll 1
            for (int r = 0; r < nr; ++r) {
                const Ctx cl = relaunder(c);
                int bb, kv, qb;
                if (loc) {
                    if (r < 8) { const int pair = (c.bid & 7) * 8 + r; bb = pair >> 1; kv = pair & 1; qb = 4 + (c.bid >> 3); }
                    else { bb = c.bid >> 3; kv = (c.bid >> 2) & 1; qb = c.bid & 3; }
                } else {
                    const int it = c.bid + r * c.nb; if (it >= nitems) break;
                    const int qi = it / 64, bk = it % 64; bb = bk >> 1; kv = bk & 1; qb = 35 - qi;
                }
                attn_item(cl, bb, kv, qb);
            }
        }
        __syncthreads();
        for (int rep = 0; rep < ((PROBE_MASK & 8) ? 2 : 1); ++rep)
        for (int ch = c.bid; ch < 512; ch += c.nb) hy_conv_item(c, l, ch);
        __syncthreads();
        break; }
    case 3: for (int rep = 0; rep < ((PROBE_MASK & 16) ? 2 : 1); ++rep) phase_hyfinal(c, l); break;
    case 4: for (int rep = 0; rep < ((PROBE_MASK & 2) ? 2 : 1); ++rep) for (int it = c.bid; it < 256; it += c.nb) scan_item_mfma(c, l, it); break;
    case 5: phase_combine(c, l, nrows); break;
    case 6: {
        bf16_t* GB = (bf16_t*)(ws + A_GBUF); bf16_t* MB = (bf16_t*)(ws + A_MBUF);
        const bf16_t* br_in[3] = {(const bf16_t*)(ws + A_OF), (const bf16_t*)(ws + P_RB), (const bf16_t*)(ws + P_RQ)};
        const int nrounds = ((nrows / 256) * 4 + c.nb - 1) / c.nb;
        for (int r = 0; r < nrounds; ++r) {
            run_gemm_round<1>(c, r, HX, wptr(c, l, OFF_WIN) + (size_t)4864 * D, nrows, D, D, GB, D, nullptr);
            run_gemm_round<2>(c, r, br_in[0], wptr(c, l, OFF_WO), nrows, D, 512, MB, D, GB);
            run_gemm_round<1>(c, r, HX, wptr(c, l, OFF_WIN) + (size_t)5888 * D, nrows, D, D, GB, D, nullptr);
            run_gemm_round<3>(c, r, br_in[1], wptr(c, l, OFF_WO + SZ_WO1), nrows, D, 512, MB, D, GB);
            run_gemm_round<1>(c, r, HX, wptr(c, l, OFF_WIN) + (size_t)6912 * D, nrows, D, D, GB, D, nullptr);
            run_gemm_round<3>(c, r, br_in[2], wptr(c, l, OFF_WO + 2 * SZ_WO1), nrows, D, 512, MB, D, GB);
        }
        break; }
    case 7: run_gemm<0>(c, (const bf16_t*)(ws + A_MBUF), wptr(c, l, OFF_WOUT), nrows, D, D, (bf16_t*)(ws + A_GBUF), D, nullptr); break;
    case 8:
        phase_resid(c, nrows, (const bf16_t*)(ws + A_GBUF), c.pp->in[7] + l * D, l, 2, l == 0, true, c.pp->in[8] + l * D, l, 3);
        break;
    case 9: run_gemm_ffn_up(c, l, 0, nrows); break;
    case 10: run_gemm_ffn_down(c, l, nrows); break;
    case 11:
        phase_resid(c, nrows, HX, c.pp->in[9] + l * D, l, 5, false, l == 0, c.pp->in[6] + D, 1, 0);
        break;
    default: break;
    }
}

__global__ void __launch_bounds__(NTHREADS, 2) fwd_megakernel(Params p, int ph_lo, int ph_hi) {
    extern __shared__ __attribute__((aligned(16))) unsigned char smem[];
    Ctx c; c.pp = (ParamsPtr)__builtin_amdgcn_kernarg_segment_ptr(); c.bid = blockIdx.x; c.nb = gridDim.x; c.tid = threadIdx.x; c.wave = __builtin_amdgcn_readfirstlane(threadIdx.x >> 6); c.lane = threadIdx.x & 63; c.lds = smem;
    volatile LAS unsigned* st = (volatile LAS unsigned*)((LAS unsigned char*)smem + LDS_ST_OFF);
    if (threadIdx.x < 4) st[threadIdx.x] = 0u;
    __syncthreads();
    unsigned* bar = (unsigned*)(((ParamsPtr)__builtin_amdgcn_kernarg_segment_ptr())->ws + WS_CTL);
    const XcdBarrier xb = xcd_barrier_post(bar, st);
    for (int ph = ph_lo; ph < ph_hi; ++ph) {
        run_phase(c, ph);
        if (ph + 1 < ph_hi) {
            if (ph == ph_lo) cg::this_grid().sync();
            else xcd_barrier(xb);
        }
    }
}

#ifndef MK_MULTI_LAUNCH
#define MK_MULTI_LAUNCH 0
#endif

extern "C" void kernel_launch(void* const* d_in, const int* in_sizes, int n_in, void* d_out, int out_size, void* d_ws, size_t ws_size, hipStream_t stream) {
    static int grid = 0;
    if (grid == 0) {
        if (n_in != 32 || ws_size < WS_END) { fprintf(stderr, "kernel_launch: need 32 inputs and >= %zu bytes of workspace (got %d, %zu)\n", (size_t)WS_END, n_in, ws_size); grid = -1; return; }
        if (hipFuncSetAttribute((const void*)fwd_megakernel, hipFuncAttributeMaxDynamicSharedMemorySize, LDS_BYTES) != hipSuccess) { fprintf(stderr, "kernel_launch: hipFuncSetAttribute failed\n"); grid = -1; return; }
        int dev = 0, cus = 0, per_cu = 0;
        hipGetDevice(&dev); hipDeviceGetAttribute(&cus, hipDeviceAttributeMultiprocessorCount, dev);
        hipOccupancyMaxActiveBlocksPerMultiprocessor(&per_cu, (const void*)fwd_megakernel, NTHREADS, LDS_BYTES);
        if (per_cu < 1) { fprintf(stderr, "kernel_launch: occupancy query returned %d\n", per_cu); per_cu = 1; }
        (void)hipGetLastError();
        grid = cus * per_cu;
    }
    if (grid < 0) return;
    if (hipMemsetAsync((char*)d_ws + WS_CTL, 0, CTL_BYTES, stream) != hipSuccess) { fprintf(stderr, "kernel_launch: memset of the barrier words failed\n"); return; }
    Params p{};
    for (int i = 0; i < 32; ++i) p.in[i] = (const float*)d_in[i];
    p.out = (float*)d_out; p.ws = (unsigned char*)d_ws;
#if MK_MULTI_LAUNCH
    for (int ph = 0; ph < NPHASES; ++ph) hipLaunchKernelGGL(fwd_megakernel, dim3(grid), dim3(NTHREADS), LDS_BYTES, stream, p, ph, ph + 1);
#else
    int lo = 0, hi = NPHASES;
    void* args[] = {&p, &lo, &hi};
    hipError_t e = hipLaunchCooperativeKernel((const void*)fwd_megakernel, dim3(grid), dim3(NTHREADS), args, LDS_BYTES, stream);
    if (e != hipSuccess) fprintf(stderr, "cooperative launch failed: %s (grid %d)\n", hipGetErrorString(e), grid);
#endif
}
```

```cpp
#include <hip/hip_runtime.h>
#include <hip/hip_cooperative_groups.h>
#include <cstdio>
#include <cstdint>
namespace cg = cooperative_groups;

#define DI __device__ __forceinline__
#define LAS __attribute__((address_space(3)))
typedef unsigned short bf16_t;
typedef short bf16x8 __attribute__((ext_vector_type(8)));
typedef short s16x4 __attribute__((ext_vector_type(4)));
typedef float f32x2 __attribute__((ext_vector_type(2)));
typedef float f32x4 __attribute__((ext_vector_type(4)));
typedef float f32x16 __attribute__((ext_vector_type(16)));
typedef unsigned u32x2 __attribute__((ext_vector_type(2)));
typedef unsigned u32x4 __attribute__((ext_vector_type(4)));
typedef __bf16 bf16x2_t __attribute__((ext_vector_type(2)));

constexpr int D = 1024, NB = 32, L = 2048, LC = 256, ML = NB * L, MC = NB * LC, M = ML + MC, LT = L + LC;
constexpr int DIN = 7936, DFF = 2816, NUP = 5632;
constexpr float EPS = 1e-6f;
constexpr int NTHREADS = 512;
constexpr int LDS_BYTES = 147456;
constexpr size_t SZ_WIN = (size_t)DIN * D * 2, SZ_WO1 = (size_t)D * 512 * 2, SZ_WOUT = (size_t)D * D * 2, SZ_WUP = (size_t)NUP * D * 2, SZ_WDN = (size_t)D * DFF * 2;
constexpr size_t OFF_WIN = 0, OFF_WO = OFF_WIN + SZ_WIN, OFF_WOUT = OFF_WO + 3 * SZ_WO1, OFF_WUP = OFF_WOUT + SZ_WOUT, OFF_WDN = OFF_WUP + SZ_WUP, SZ_WL = OFF_WDN + SZ_WDN;
constexpr size_t WS_W = 0;
constexpr size_t WS_MODS = WS_W + 2 * SZ_WL;
constexpr size_t WS_RL = WS_MODS + (size_t)2 * 33 * 6144 * 4;
constexpr size_t WS_RC = WS_RL + (size_t)2 * 512 * 4096 * 2;
constexpr size_t WS_ROPE = WS_RC + (size_t)512 * 512 * 4;
constexpr size_t WS_CTXR = WS_ROPE + (size_t)2048 * 32 * 2 * 4;
constexpr size_t WS_CH = WS_CTXR + (size_t)MC * D * 4;
constexpr size_t WS_HX = WS_CH + (size_t)MC * 512 * 2;
constexpr size_t P_R1 = WS_HX + (size_t)M * D * 2;
constexpr size_t P_RQ = P_R1 + (size_t)M * 2560 * 2;
constexpr size_t P_RK = P_RQ + (size_t)M * 512 * 2;
constexpr size_t P_RV = P_RK + (size_t)NB * 2 * LT * 64 * 2;
constexpr size_t P_RU = P_RV + (size_t)NB * 2 * LT * 64 * 2;
constexpr size_t P_RX = P_RU + (size_t)512 * 128 * 64 * 16;
constexpr size_t P_RY = P_RX + (size_t)ML * 512 * 2;
constexpr size_t P_RB = P_RY + (size_t)512 * 2048 * 32 * 2;
constexpr size_t WS_CTL = P_RB + (size_t)M * 512 * 2;
constexpr size_t CTL_BYTES = 16384;
constexpr size_t WS_END = WS_CTL + CTL_BYTES;
constexpr int LDS_ST_OFF = LDS_BYTES - 16;
constexpr size_t A_OF = P_RU, A_OB = P_RU + (size_t)M * 512 * 2;
constexpr size_t A_GBUF = P_R1, A_MBUF = P_R1 + (size_t)M * D * 2;
constexpr size_t A_ACT = P_R1, A_ZUP = P_R1 + (size_t)M * DFF * 2;
static_assert(A_OB + (size_t)M * 512 * 2 <= P_RB, "scan outputs overlay");
static_assert(A_MBUF + (size_t)M * D * 2 <= P_RQ, "merge overlay");
static_assert(A_ZUP + (size_t)(M / 256) * 4 * NUP * 2 <= WS_CTL && (A_ZUP % 256) == 0, "ffn overlay");
static_assert(WS_END <= ((size_t)1 << 30), "workspace over 1 GiB");
static_assert((WS_MODS % 256) == 0 && (WS_RL % 256) == 0 && (WS_HX % 256) == 0 && (P_R1 % 256) == 0 && (P_RU % 256) == 0, "alignment");

#ifndef PROBE_MASK
#define PROBE_MASK 0
#endif
struct Params { const float* in[32]; float* out; unsigned char* ws; };

DI float bf_lo(unsigned u) { return __uint_as_float(u << 16); }
DI float bf_hi(unsigned u) { return __uint_as_float(u & 0xffff0000u); }
DI float bf2f(bf16_t v) { return __uint_as_float((unsigned)v << 16); }
DI unsigned pk2(float lo, float hi) { f32x2 v = {lo, hi}; bf16x2_t b = __builtin_convertvector(v, bf16x2_t); return __builtin_bit_cast(unsigned, b); }
DI bf16_t f2bf(float f) { return (bf16_t)(pk2(f, 0.f) & 0xffffu); }
DI float wave_sum(float v) {
#pragma unroll
    for (int o = 32; o > 0; o >>= 1) v += __shfl_xor(v, o);
    return v;
}
DI float sigmoidf_(float x) { return __builtin_amdgcn_rcpf(1.f + __expf(-x)); }
DI float siluf_(float x) { return x * __builtin_amdgcn_rcpf(1.f + __expf(-x)); }
DI int crow(int reg, int h) { return (reg & 3) + 8 * (reg >> 2) + 4 * h; }
namespace pg8 {
#define PG8_LAS __attribute__((address_space(3)))
typedef unsigned short bf16_t;
typedef short bf16x8 __attribute__((ext_vector_type(8)));
typedef float f32x4 __attribute__((ext_vector_type(4)));
typedef unsigned u32x4 __attribute__((ext_vector_type(4)));
constexpr int BM = 256, BK = 64, HALF = 128, HTB = HALF * BK * 2  , STAGE_BYTES = 8 * HTB, NXCD = 8, WGM = 8;

__host__ __device__ __forceinline__ int lds_byte(int r, int c) { const int st = (r >> 4) * 2 + (c >> 5), rr = r & 15, cc = c & 31, ob = rr * 64 + cc * 2; return st * 1024 + (ob ^ (((ob >> 9) & 1) << 5)); }
__host__ __device__ __forceinline__ void stage_rc(int b, int& R, int& C) { const int st = b / 1024, sb = b % 1024, swz = sb ^ (((sb >> 9) & 1) << 5); R = (st >> 1) * 16 + swz / 64; C = (st & 1) * 32 + (swz % 64) / 2; }
__host__ __device__ __forceinline__ int perm32(int rho) { const int n = rho >> 4, i = rho & 15; return 8 * (i >> 2) + 4 * n + (i & 3); }

struct Unit { int pm, pn; };
struct Gemm { const bf16_t* A; const bf16_t* Bt; int M, N, K; };

struct StaticOrder {
    int nM, nN, nwg, G, c;
    __host__ __device__ void init(int M, int N, int G_, int c_) { nM = M / BM; nN = N / BM; nwg = nM * nN; G = G_; c = c_; }
    __host__ __device__ bool next(int i, Unit& u) const {
        const long L = (long)i * G + c; if (L >= nwg) return false;
        int wgid = (int)L; { const int q = nwg / NXCD, r = nwg % NXCD, xcd = wgid % NXCD, off = wgid / NXCD; wgid = (xcd < r ? xcd * (q + 1) : r * (q + 1) + (xcd - r) * q) + off; }
        const int nig = WGM * nN, gid = wgid / nig, fm = gid * WGM, gsz = (nM - fm) < WGM ? (nM - fm) : WGM;
        u.pm = fm + ((wgid % nig) % gsz); u.pn = (wgid % nig) / gsz; return true;
    }
    __device__ __forceinline__ void a_ready(const Unit&) const {}
    __device__ __forceinline__ void done(const Unit&) const {}
};
typedef float pk_f32x2 __attribute__((ext_vector_type(2)));
typedef __bf16 pk_bf16x2 __attribute__((ext_vector_type(2)));
__device__ __forceinline__ unsigned cvt_pk_bf16(float lo, float hi) { pk_f32x2 v = {lo, hi}; pk_bf16x2 b = __builtin_convertvector(v, pk_bf16x2); return __builtin_bit_cast(unsigned, b); }

template <int MODE> struct EpiT {
    static constexpr bool PERM = true, AFTER_DRAIN = false, PERMA = false;
    bf16_t* O; int ldc; const bf16_t* G;
    __device__ __forceinline__ void operator()(const f32x4 (&acc)[2][2][4][2], const Unit& u, int wr, int wc, int fr, int fq) const {
        const int row0 = u.pm * BM + wr * 64 + fr, col0 = u.pn * BM + wc * 32 + 8 * fq;
#pragma unroll
        for (int ai = 0; ai < 2; ++ai)
#pragma unroll
            for (int m = 0; m < 4; ++m) {
                const size_t roff = (size_t)(row0 + ai * HALF + m * 16) * ldc + col0;
#pragma unroll
                for (int bj = 0; bj < 2; ++bj) {
                    f32x4 v0 = acc[ai][bj][m][0], v1 = acc[ai][bj][m][1];
                    const size_t off = roff + bj * HALF;
                    if (MODE == 1) {
#pragma unroll
                        for (int j = 0; j < 4; ++j) { v0[j] = __builtin_amdgcn_rcpf(1.f + __expf(-v0[j])); v1[j] = __builtin_amdgcn_rcpf(1.f + __expf(-v1[j])); }
                    }
                    if (MODE == 2 || MODE == 3) {
                        const u32x4 g = *(const u32x4*)(G + off);
                        v0[0] *= __uint_as_float(g.x << 16); v0[1] *= __uint_as_float(g.x & 0xffff0000u);
                        v0[2] *= __uint_as_float(g.y << 16); v0[3] *= __uint_as_float(g.y & 0xffff0000u);
                        v1[0] *= __uint_as_float(g.z << 16); v1[1] *= __uint_as_float(g.z & 0xffff0000u);
                        v1[2] *= __uint_as_float(g.w << 16); v1[3] *= __uint_as_float(g.w & 0xffff0000u);
                    }
                    if (MODE == 3) {
                        const u32x4 o = *(const u32x4*)(O + off);
                        v0[0] += __uint_as_float(o.x << 16); v0[1] += __uint_as_float(o.x & 0xffff0000u);
                        v0[2] += __uint_as_float(o.y << 16); v0[3] += __uint_as_float(o.y & 0xffff0000u);
                        v1[0] += __uint_as_float(o.z << 16); v1[1] += __uint_as_float(o.z & 0xffff0000u);
                        v1[2] += __uint_as_float(o.w << 16); v1[3] += __uint_as_float(o.w & 0xffff0000u);
                    }
                    u32x4 w; w.x = cvt_pk_bf16(v0[0], v0[1]); w.y = cvt_pk_bf16(v0[2], v0[3]); w.z = cvt_pk_bf16(v1[0], v1[1]); w.w = cvt_pk_bf16(v1[2], v1[3]);
                    *(u32x4*)(O + off) = w;
                }
            }
    }
};

struct EpiFfn {
    static constexpr bool PERM = true, AFTER_DRAIN = false, PERMA = true;
    bf16_t* ACT; bf16_t* EDGE; const float* cw; const float* cb; PG8_LAS float* X;
    __device__ __forceinline__ void operator()(const f32x4 (&acc)[2][2][4][2], const Unit& u, int wr, int wc, int fr, int fq) const {
        const int ch0 = u.pn * 128 + wc * 32 + 8 * fq, tau0 = wr * 128 + fr * 8, xo = ((wc * 4 + fq) * 2) * 8;
        if (wr == 0 && fr == 15) {
#pragma unroll
            for (int bj = 0; bj < 2; ++bj)
#pragma unroll
                for (int n = 0; n < 2; ++n) *(PG8_LAS f32x4*)(X + xo + bj * 8 + 4 * n) = acc[1][bj][3][n];
        }
        if (wr == 1 && fr == 0) {
#pragma unroll
            for (int bj = 0; bj < 2; ++bj)
#pragma unroll
                for (int n = 0; n < 2; ++n) *(PG8_LAS f32x4*)(X + 256 + xo + bj * 8 + 4 * n) = acc[0][bj][0][n];
        }
        asm volatile("s_waitcnt lgkmcnt(0)\n\ts_barrier" ::: "memory");
        const bool lo_edge = (wr == 0 && fr == 0), hi_edge = (wr == 1 && fr == 15);
#pragma unroll
        for (int n = 0; n < 2; ++n) {
            const int c4 = ch0 + 4 * n;
            f32x4 wa[3], wb[3];
#pragma unroll
            for (int tp = 0; tp < 3; ++tp) { wa[tp] = *(const f32x4*)(cw + tp * 5632 + c4); wb[tp] = *(const f32x4*)(cw + tp * 5632 + 2816 + c4); }
            const f32x4 ba = *(const f32x4*)(cb + c4), bb = *(const f32x4*)(cb + 2816 + c4);
            f32x4 pa, pb, na, nb;
#pragma unroll
            for (int j = 0; j < 4; ++j) {
                pa[j] = __shfl_up(acc[1][0][3][n][j], 1, 16); pb[j] = __shfl_up(acc[1][1][3][n][j], 1, 16);
                na[j] = __shfl_down(acc[0][0][0][n][j], 1, 16); nb[j] = __shfl_down(acc[0][1][0][n][j], 1, 16);
            }
            if (fr == 0 && wr == 1) { pa = *(const PG8_LAS f32x4*)(X + xo + 4 * n); pb = *(const PG8_LAS f32x4*)(X + xo + 8 + 4 * n); }
            if (fr == 15 && wr == 0) { na = *(const PG8_LAS f32x4*)(X + 256 + xo + 4 * n); nb = *(const PG8_LAS f32x4*)(X + 256 + xo + 8 + 4 * n); }
#pragma unroll
            for (int q = 0; q < 8; ++q) {
                const f32x4 ap = (q == 0) ? pa : acc[(q - 1 < 0 ? 0 : q - 1) >> 2][0][(q - 1 < 0 ? 0 : q - 1) & 3][n];
                const f32x4 bp = (q == 0) ? pb : acc[(q - 1 < 0 ? 0 : q - 1) >> 2][1][(q - 1 < 0 ? 0 : q - 1) & 3][n];
                const f32x4 an = (q == 7) ? na : acc[(q + 1 > 7 ? 7 : q + 1) >> 2][0][(q + 1 > 7 ? 7 : q + 1) & 3][n];
                const f32x4 bn = (q == 7) ? nb : acc[(q + 1 > 7 ? 7 : q + 1) >> 2][1][(q + 1 > 7 ? 7 : q + 1) & 3][n];
                const f32x4 ac = acc[q >> 2][0][q & 3][n], bc = acc[q >> 2][1][q & 3][n];
                const f32x4 ua = ap * wa[0] + ac * wa[1] + an * wa[2] + ba, ub = bp * wb[0] + bc * wb[1] + bn * wb[2] + bb;
                float o[4];
#pragma unroll
                for (int j = 0; j < 4; ++j) o[j] = ua[j] * __builtin_amdgcn_rcpf(1.f + __expf(-ua[j])) * ub[j];
                const bool valid = !((q == 0 && lo_edge) || (q == 7 && hi_edge));
                if (valid) { pk_f32x2 w2; unsigned lo = cvt_pk_bf16(o[0], o[1]), hi = cvt_pk_bf16(o[2], o[3]); (void)w2;
                    typedef unsigned u32x2_t __attribute__((ext_vector_type(2)));
                    *(u32x2_t*)(ACT + (size_t)(u.pm * BM + tau0 + q) * 2816 + c4) = (u32x2_t){lo, hi}; }
            }
        }
        if (lo_edge || hi_edge) {
            const int e0 = lo_edge ? 0 : 2, ai = lo_edge ? 0 : 1;
#pragma unroll
            for (int e = 0; e < 2; ++e)
#pragma unroll
                for (int bj = 0; bj < 2; ++bj) {
                    const f32x4 v0 = lo_edge ? acc[0][bj][e][0] : acc[1][bj][2 + e][0], v1 = lo_edge ? acc[0][bj][e][1] : acc[1][bj][2 + e][1];
                    u32x4 w; w.x = cvt_pk_bf16(v0[0], v0[1]); w.y = cvt_pk_bf16(v0[2], v0[3]); w.z = cvt_pk_bf16(v1[0], v1[1]); w.w = cvt_pk_bf16(v1[2], v1[3]);
                    *(u32x4*)(EDGE + ((size_t)u.pm * 4 + e0 + e) * 5632 + bj * 2816 + ch0) = w;
                }
            (void)ai;
        }
    }
};
template <class Epi, class Sched, bool ALIGN_EPI = false, bool SP2 = false>
__device__ __forceinline__ void gemm_phase(PG8_LAS unsigned char* lds, const Gemm g, const Sched& S, const Epi& E) {
    int tid_l = threadIdx.x; asm volatile("" : "+v"(tid_l));
    const int tid = tid_l, wid = __builtin_amdgcn_readfirstlane(tid >> 6), lane = tid & 63, wr = wid >> 2, wc = wid & 3, fr = lane & 15, fq = lane >> 4;
    const int K = g.K, nt = K / BK;
    unsigned voffA[2], voffB[2];
#pragma unroll
    for (int i = 0; i < 2; ++i) { int R, C; stage_rc(tid * 16 + i * 8192, R, C); const int Rb = Epi::PERM ? ((R & ~31) + perm32(R & 31)) : R;
        const int Ra = Epi::PERMA ? ((R >> 6) * 128 + (R & 15) * 8 + ((R >> 4) & 3)) : R;
        voffA[i] = (unsigned)(Ra * K + C) * 2u; voffB[i] = (unsigned)(Rb * K + C) * 2u; }
    const size_t kstep = (size_t)(BK * 2);
    const size_t hstep = (size_t)HALF * K * 2;
    const size_t hstepA = Epi::PERMA ? (size_t)4 * K * 2 : hstep;
    const size_t tstep = 2 * hstep;
    const unsigned ldsw = (unsigned)wid * 1024u;
    const int aoff = lds_byte(wr * 64 + fr, fq * 8), boff = lds_byte(wc * 32 + fr, fq * 8);
#define PG8_SA(b, h) (((b) * 2 + (h)) * HTB)
#define PG8_SB(b, h) ((4 + (b) * 2 + (h)) * HTB)
#define PG8_STAGE(bufoff, gbase, voff) do { _Pragma("unroll") for (int _i = 0; _i < 2; ++_i) \
        __builtin_amdgcn_global_load_lds((const unsigned*)((const char*)(gbase) + (voff)[_i]), (PG8_LAS unsigned*)(lds + (bufoff) + ldsw + _i * 8192), 16, 0, 0); } while (0)
#define PG8_LDA(dst, b, h) do { _Pragma("unroll") for (int m = 0; m < 4; ++m) _Pragma("unroll") for (int k = 0; k < 2; ++k) dst[m][k] = *(const PG8_LAS bf16x8*)(lds + PG8_SA(b, h) + aoff + m * 2048 + k * 1024); } while (0)
#define PG8_LDB(dst, b, h) do { _Pragma("unroll") for (int n = 0; n < 2; ++n) _Pragma("unroll") for (int k = 0; k < 2; ++k) dst[n][k] = *(const PG8_LAS bf16x8*)(lds + PG8_SB(b, h) + boff + n * 2048 + k * 1024); } while (0)
#define PG8_MMA(ai, bj, At, Bt) do { __builtin_amdgcn_s_setprio(1); _Pragma("unroll") for (int m = 0; m < 4; ++m) _Pragma("unroll") for (int n = 0; n < 2; ++n) _Pragma("unroll") for (int k = 0; k < 2; ++k) \
        acc[ai][bj][m][n] = __builtin_amdgcn_mfma_f32_16x16x32_bf16(Bt[n][k], At[m][k], acc[ai][bj][m][n], 0, 0, 0); __builtin_amdgcn_s_setprio(0); } while (0)
#define PG8_WAIT_V(n) asm volatile("s_waitcnt vmcnt(" #n ")" ::: "memory")
#define PG8_WAIT_L(n) asm volatile("s_waitcnt lgkmcnt(" #n ")" ::: "memory")
#define PG8_BAR __builtin_amdgcn_s_barrier()
#define PG8_SCHED __builtin_amdgcn_sched_barrier(0)
    Unit cur, nxt; int ui = 0;
    if (!S.next(0, cur)) return;
    f32x4 acc[2][2][4][2];
#pragma unroll
    for (int a = 0; a < 2; ++a)
#pragma unroll
        for (int b = 0; b < 2; ++b)
#pragma unroll
            for (int m = 0; m < 4; ++m)
#pragma unroll
                for (int n = 0; n < 2; ++n) acc[a][b][m][n] = (f32x4){0.f, 0.f, 0.f, 0.f};
    bf16x8 At[4][2], B0[2][2], B1[2][2];
    const char* cA = (const char*)g.A + (size_t)cur.pm * tstep; const char* cB = (const char*)g.Bt + (size_t)cur.pn * tstep;
    S.a_ready(cur);
    if constexpr (SP2) {
        PG8_STAGE(PG8_SB(0, 0), cB, voffB); PG8_STAGE(PG8_SB(0, 1), cB + hstep, voffB); PG8_STAGE(PG8_SA(0, 0), cA, voffA); PG8_STAGE(PG8_SA(0, 1), cA + hstepA, voffA);
        if (wr == 1) PG8_BAR;
        PG8_WAIT_V(2); PG8_BAR;
        PG8_STAGE(PG8_SB(1, 0), cB + kstep, voffB); PG8_STAGE(PG8_SA(1, 0), cA + kstep, voffA); PG8_STAGE(PG8_SB(1, 1), cB + hstep + kstep, voffB);
        PG8_WAIT_V(6); PG8_BAR;
    } else {
        PG8_STAGE(PG8_SB(0, 0), cB, voffB); PG8_STAGE(PG8_SA(0, 0), cA, voffA); PG8_STAGE(PG8_SB(0, 1), cB + hstep, voffB); PG8_STAGE(PG8_SA(0, 1), cA + hstepA, voffA);
        if (wr == 1) PG8_BAR;
        PG8_WAIT_V(4); PG8_BAR;
        PG8_STAGE(PG8_SB(1, 0), cB + kstep, voffB); PG8_STAGE(PG8_SA(1, 0), cA + kstep, voffA); PG8_STAGE(PG8_SB(1, 1), cB + hstep + kstep, voffB);
        PG8_WAIT_V(6); PG8_BAR;
    }
    for (;;) {
        const bool has_next = S.next(ui + 1, nxt);
        const char* nA = has_next ? (const char*)g.A + (size_t)nxt.pm * tstep : cA; const char* nB = has_next ? (const char*)g.Bt + (size_t)nxt.pn * tstep : cB;
        for (int t = 0; t < nt; t += 2) {
            const bool last = (t == nt - 2);
            const char* a1 = cA + (size_t)(t + 1) * kstep;
            const char* a2 = last ? nA : cA + (size_t)(t + 2) * kstep; const char* b2 = last ? nB : cB + (size_t)(t + 2) * kstep;
            const char* a3 = a2 + kstep; const char* b3 = b2 + kstep;
            if (last && has_next) S.a_ready(nxt);
            if constexpr (SP2) {
            PG8_LDB(B0, 0, 0); PG8_LDB(B1, 0, 1); PG8_SCHED; PG8_LDA(At, 0, 0); PG8_STAGE(PG8_SA(1, 1), a1 + hstepA, voffA);
            PG8_WAIT_V(8); PG8_WAIT_L(0); PG8_BAR; PG8_MMA(0, 0, At, B0); PG8_MMA(0, 1, At, B1); PG8_BAR; PG8_SCHED;
            PG8_LDA(At, 0, 1); PG8_STAGE(PG8_SB(0, 0), b2, voffB); PG8_STAGE(PG8_SB(0, 1), b2 + hstep, voffB); PG8_STAGE(PG8_SA(0, 0), a2, voffA);
            PG8_WAIT_V(8); PG8_WAIT_L(0); PG8_BAR; PG8_MMA(1, 0, At, B0); PG8_MMA(1, 1, At, B1); PG8_BAR; PG8_SCHED;
            PG8_LDB(B0, 1, 0); PG8_LDB(B1, 1, 1); PG8_SCHED; PG8_LDA(At, 1, 0); PG8_STAGE(PG8_SA(0, 1), a2 + hstepA, voffA);
            PG8_WAIT_V(8); PG8_WAIT_L(0); PG8_BAR; PG8_MMA(0, 0, At, B0); PG8_MMA(0, 1, At, B1); PG8_BAR; PG8_SCHED;
            PG8_LDA(At, 1, 1); PG8_STAGE(PG8_SB(1, 0), b3, voffB); PG8_STAGE(PG8_SB(1, 1), b3 + hstep, voffB); PG8_STAGE(PG8_SA(1, 0), a3, voffA);
            PG8_WAIT_V(8); PG8_WAIT_L(0); PG8_BAR; PG8_MMA(1, 0, At, B0); PG8_MMA(1, 1, At, B1); PG8_BAR; PG8_SCHED;
            } else {
            PG8_LDB(B0, 0, 0); PG8_SCHED; PG8_LDA(At, 0, 0); PG8_STAGE(PG8_SA(1, 1), a1 + hstepA, voffA);
            PG8_WAIT_L(8); PG8_BAR; PG8_WAIT_L(0); PG8_MMA(0, 0, At, B0); PG8_BAR; PG8_SCHED;
            PG8_LDB(B1, 0, 1); PG8_STAGE(PG8_SB(0, 0), b2, voffB);
            PG8_BAR; PG8_WAIT_L(0); PG8_MMA(0, 1, At, B1); PG8_BAR;
            PG8_LDA(At, 0, 1); PG8_STAGE(PG8_SA(0, 0), a2, voffA);
            PG8_BAR; PG8_WAIT_L(0); PG8_MMA(1, 0, At, B0); PG8_BAR; PG8_SCHED;
            PG8_STAGE(PG8_SB(0, 1), b2 + hstep, voffB);
            PG8_WAIT_V(6); PG8_BAR; PG8_MMA(1, 1, At, B1); PG8_BAR;
            PG8_LDB(B0, 1, 0); PG8_SCHED; PG8_LDA(At, 1, 0); PG8_STAGE(PG8_SA(0, 1), a2 + hstepA, voffA);
            PG8_WAIT_L(8); PG8_BAR; PG8_WAIT_L(0); PG8_MMA(0, 0, At, B0); PG8_BAR; PG8_SCHED;
            PG8_LDB(B1, 1, 1); PG8_STAGE(PG8_SB(1, 0), b3, voffB);
            PG8_BAR; PG8_WAIT_L(0); PG8_MMA(0, 1, At, B1); PG8_BAR;
            PG8_LDA(At, 1, 1); PG8_STAGE(PG8_SA(1, 0), a3, voffA);
            PG8_BAR; PG8_WAIT_L(0); PG8_MMA(1, 0, At, B0); PG8_BAR; PG8_SCHED;
            PG8_STAGE(PG8_SB(1, 1), b3 + hstep, voffB);
            PG8_WAIT_V(6); PG8_BAR; PG8_MMA(1, 1, At, B1); PG8_BAR;
            }
        }
        if constexpr (ALIGN_EPI) { if (wr == 0) PG8_BAR; }
        if constexpr (!Epi::AFTER_DRAIN) { E(acc, cur, wr, wc, fr, fq); S.done(cur); }
        if (!has_next) break;
#pragma unroll
        for (int a = 0; a < 2; ++a)
#pragma unroll
            for (int b = 0; b < 2; ++b)
#pragma unroll
                for (int m = 0; m < 4; ++m)
#pragma unroll
                    for (int n = 0; n < 2; ++n) acc[a][b][m][n] = (f32x4){0.f, 0.f, 0.f, 0.f};
        cur = nxt; cA = nA; cB = nB; ++ui;
        if constexpr (ALIGN_EPI) { if (wr == 1) PG8_BAR; }
    }
    PG8_WAIT_V(0);
    if constexpr (!ALIGN_EPI) { if (wr == 0) PG8_BAR; }
    PG8_BAR;
    if constexpr (Epi::AFTER_DRAIN) { E.fused(acc, cur, wr, wc, fr, fq, lds, wid, lane); S.done(cur); }
#undef PG8_SA
#undef PG8_SB
#undef PG8_STAGE
#undef PG8_LDA
#undef PG8_LDB
#undef PG8_MMA
#undef PG8_WAIT_V
#undef PG8_WAIT_L
#undef PG8_BAR
#undef PG8_SCHED
}
}
#define XB_TMO      128
#define XB_XCNT(j)  (256  + 64 * (j))
#define XB_XSUB(j)  (1280 + 64 * (j))
#define XB_XGEN(j)  (2304 + 64 * (j))
#define XB_TOP      3328
#define XB_TOPGEN   3392
#define XCD_BAR_WORDS 3456
#define XB_SPIN_CAP (1u << 18)

__device__ __forceinline__ unsigned xb_ld(unsigned* p)              { return __hip_atomic_load(p, __ATOMIC_RELAXED, __HIP_MEMORY_SCOPE_AGENT); }
__device__ __forceinline__ unsigned xb_add(unsigned* p, unsigned v) { return __hip_atomic_fetch_add(p, v, __ATOMIC_RELAXED, __HIP_MEMORY_SCOPE_AGENT); }
__device__ __forceinline__ unsigned xb_xcc_id() { return (unsigned)__builtin_amdgcn_s_getreg((3 << 11) | 20) & 0xFu; }
#define XB_SPIN(cond, bar) do { unsigned _sp = 0; while (cond) { __builtin_amdgcn_s_sleep(1); \
    if ((++_sp & 255u) == 0u) { if (xb_ld(&(bar)[XB_TMO])) break; if (_sp > XB_SPIN_CAP) { atomicAdd(&(bar)[XB_TMO], 1u); break; } } } } while (0)

struct XcdBarrier {
    unsigned* bar; unsigned x;
    volatile LAS unsigned* st;
};

__device__ __forceinline__ XcdBarrier xcd_barrier_post(unsigned* bar, volatile LAS unsigned* st) {
    XcdBarrier b; b.bar = bar; b.x = xb_xcc_id(); b.st = st;
    if (threadIdx.x == 0) (void)xb_add(&bar[XB_XCNT(b.x)], 1u);
    return b;
}
__device__ __forceinline__ void xcd_barrier_complete(unsigned* bar, unsigned x, unsigned& nloc, unsigned& nx) {
    const unsigned G = gridDim.x * gridDim.y * gridDim.z;
    unsigned sum, cnt, mine, sp = 0u;
    for (;;) {
        sum = 0u; cnt = 0u; mine = 0u;
#pragma unroll
        for (unsigned j = 0; j < 16; ++j) { const unsigned c = xb_ld(&bar[XB_XCNT(j)]); sum += c; cnt += (c > 0u) ? 1u : 0u; mine = (j == x) ? c : mine; }
        if (sum == G) break;
        __builtin_amdgcn_s_sleep(1);
        if ((++sp & 255u) == 0u) { if (xb_ld(&bar[XB_TMO])) break; if (sp > XB_SPIN_CAP) { atomicAdd(&bar[XB_TMO], 1u); break; } }
    }
    nloc = mine > 0u ? mine : 1u; nx = cnt > 0u ? cnt : 1u;
}

__device__ __forceinline__ void xcd_barrier(const XcdBarrier& b) {
    asm volatile("s_waitcnt vmcnt(0)" ::: "memory");
    __syncthreads();
    if (threadIdx.x == 0) {
        unsigned* bar = b.bar;
        __builtin_amdgcn_s_waitcnt(0);
        unsigned nloc = b.st[0], nx = b.st[1];
        if (nloc == 0u) { xcd_barrier_complete(bar, b.x, nloc, nx); b.st[0] = nloc; b.st[1] = nx; }
        const unsigned old = xb_add(&bar[XB_XSUB(b.x)], 1u);
        const unsigned gen = old / nloc;
        if (old + 1u == (gen + 1u) * nloc) {
            __builtin_amdgcn_fence(__ATOMIC_RELEASE, "agent");
            asm volatile("s_waitcnt vmcnt(0)" ::: "memory");
            const unsigned og = xb_add(&bar[XB_TOP], 1u);
            const unsigned tg = og / nx;
            if (og + 1u == (tg + 1u) * nx) xb_add(&bar[XB_TOPGEN], 1u);
            else XB_SPIN(xb_ld(&bar[XB_TOPGEN]) == tg, bar);
            __builtin_amdgcn_fence(__ATOMIC_ACQUIRE, "agent");
            xb_add(&bar[XB_XGEN(b.x)], 1u);
            asm volatile("s_waitcnt vmcnt(0)" ::: "memory");
        } else {
            XB_SPIN(xb_ld(&bar[XB_XGEN(b.x)]) == gen, bar);
            __builtin_amdgcn_fence(__ATOMIC_ACQUIRE, "agent");
            asm volatile("s_waitcnt vmcnt(0)" ::: "memory");
        }
    }
    __syncthreads();
}


typedef const __attribute__((address_space(4))) Params* ParamsPtr;
struct Ctx { ParamsPtr pp; int bid, nb, tid, wave, lane; unsigned char* lds; };


DI float4 nt_load4(const float* p) { const f32x4 v = __builtin_nontemporal_load((const f32x4*)p); return make_float4(v[0], v[1], v[2], v[3]); }
DI void nt_store4(float* p, float4 o) { const f32x4 v = {o.x, o.y, o.z, o.w}; __builtin_nontemporal_store(v, (f32x4*)p); }
DI void lds_barrier() { asm volatile("s_waitcnt lgkmcnt(0)\n\ts_barrier" ::: "memory"); }
DI Ctx relaunder(const Ctx& c0) {
    Ctx c = c0; asm volatile("" : "+v"(c.tid)); c.lane = c.tid & 63; c.wave = __builtin_amdgcn_readfirstlane(c.tid >> 6); return c;
}
DI const float* mods_ptr(const Ctx& c, int l, int mrow) { return (const float*)(c.pp->ws + WS_MODS) + (size_t)(l * 33 + mrow) * 6144; }
DI bf16_t* wptr(const Ctx& c, int l, size_t off) { return (bf16_t*)(c.pp->ws + WS_W + (size_t)l * SZ_WL + off); }

DI void convert_tile4(const float* __restrict__ src, bf16_t* __restrict__ dst, int K, int N, int pair, float* lds, int tid, bool up_perm = false) {
    const int ntn = N >> 8, tk2 = pair / ntn, tn = pair % ntn;
    const int c4 = (tid & 63) * 4, r0 = tid >> 6;
    float4 v[2][8];
#pragma unroll
    for (int h = 0; h < 2; ++h)
#pragma unroll
        for (int i = 0; i < 8; ++i) v[h][i] = *(const float4*)(src + (size_t)((tk2 * 2 + h) * 64 + r0 + 8 * i) * N + tn * 256 + c4);
#pragma unroll
    for (int h = 0; h < 2; ++h)
#pragma unroll
        for (int i = 0; i < 8; ++i) { float* q = lds + h * (64 * 257) + (r0 + 8 * i) * 257 + c4; q[0] = v[h][i].x; q[1] = v[h][i].y; q[2] = v[h][i].z; q[3] = v[h][i].w; }
    __syncthreads();
    const int n = tid >> 1, kh = (tid & 1) * 32;
    int drow = tn * 256 + n;
    if (up_perm) { const int part = drow / DFF, ch = drow % DFF; drow = (ch >> 7) * 256 + part * 128 + (ch & 127); }
#pragma unroll
    for (int h = 0; h < 2; ++h) {
        bf16_t* dp = dst + (size_t)drow * K + (tk2 * 2 + h) * 64 + kh;
#pragma unroll
        for (int q = 0; q < 4; ++q) {
            const float* lp = lds + h * (64 * 257) + (kh + 8 * q) * 257 + n;
            u32x4 w;
            w.x = pk2(lp[0], lp[257]); w.y = pk2(lp[2 * 257], lp[3 * 257]); w.z = pk2(lp[4 * 257], lp[5 * 257]); w.w = pk2(lp[6 * 257], lp[7 * 257]);
            *(u32x4*)(dp + 8 * q) = w;
        }
    }
    __syncthreads();
}

DI void adaln_item(const Ctx& c, int item) {
    float* lds = (float*)c.lds;
    const int l = item / 96, cgp = item % 96, tid = c.tid;
    for (int i = tid; i < 33 * 1024; i += NTHREADS) { const int r = i >> 10, k = i & 1023; const float v = (r < 32) ? c.pp->in[1][r * 1024 + k] : c.pp->in[3][k]; lds[i] = siluf_(v); }
    __syncthreads();
    const int cl = tid & 63, ks = tid >> 6, col = cgp * 64 + cl;
    const float* W = c.pp->in[4] + (size_t)l * 1024 * 6144 + col;
    float acc[33];
#pragma unroll
    for (int r = 0; r < 33; ++r) acc[r] = 0.f;
    for (int k = ks * 128; k < ks * 128 + 128; k += 4) {
        const float w0 = W[(size_t)k * 6144], w1 = W[(size_t)(k + 1) * 6144], w2 = W[(size_t)(k + 2) * 6144], w3 = W[(size_t)(k + 3) * 6144];
#pragma unroll
        for (int r = 0; r < 33; ++r) { const float4 s = *(const float4*)(lds + r * 1024 + k); acc[r] += s.x * w0 + s.y * w1 + s.z * w2 + s.w * w3; }
    }
    __syncthreads();
#pragma unroll
    for (int r = 0; r < 33; ++r) lds[(ks * 33 + r) * 64 + cl] = acc[r];
    __syncthreads();
    float* mods = (float*)(c.pp->ws + WS_MODS);
    for (int i = tid; i < 33 * 64; i += NTHREADS) {
        const int r = i >> 6, cc = i & 63; float s = 0.f;
#pragma unroll
        for (int q = 0; q < 8; ++q) s += lds[(q * 33 + r) * 64 + cc];
        const int gc = cgp * 64 + cc;
        mods[(size_t)(l * 33 + r) * 6144 + gc] = s + c.pp->in[5][l * 6144 + gc];
    }
    __syncthreads();
}

DI void hyfilt_item(const Ctx& c, int item) {
    const int lane = c.lane;
    const int pi = item * 8 + c.wave;
    int l, Lx, pos; bool isctx;
    if (pi < 2048) { l = 0; Lx = 2048; pos = pi; isctx = false; }
    else if (pi < 4096) { l = 1; Lx = 2048; pos = pi - 2048; isctx = false; }
    else { l = 0; Lx = 256; pos = pi - 4096; isctx = true; }
    const float tl = (float)pos / (float)(Lx - 1);
    const float w = (6.2831855f * (float)pos) / (float)Lx;
    float zv = 0.f;
    if (lane == 0) zv = tl;
    else if (lane <= 16) { const float f = 1e-4f + (float)(lane - 1) * ((15.f - 1e-4f) / 15.f); zv = cosf(f * w); }
    else if (lane <= 32) { const float f = 1e-4f + (float)(lane - 17) * ((15.f - 1e-4f) / 15.f); zv = -sinf(f * w); }
    const float* w1 = c.pp->in[17] + l * 33 * 64; const float* b1 = c.pp->in[18] + l * 64; const float* wi = c.pp->in[19] + l * 2 * 64 * 64;
    const float* bi = c.pp->in[20] + l * 2 * 64; const float* fr = c.pp->in[21] + l * 64; const float* wl = c.pp->in[22] + (size_t)l * 64 * 1024;
    const float* bias = c.pp->in[23] + l * 512;
    const float frq = fr[lane];
    float a = b1[lane];
    for (int i = 0; i < 33; ++i) a += __shfl(zv, i) * w1[i * 64 + lane];
    float h = sinf(frq * a);
    for (int j = 0; j < 2; ++j) {
        float a2 = bi[j * 64 + lane];
        for (int k = 0; k < 64; ++k) a2 += __shfl(h, k) * wi[(j * 64 + k) * 64 + lane];
        h = sinf(frq * a2);
    }
    float o[16];
#pragma unroll
    for (int i = 0; i < 16; ++i) o[i] = 0.f;
    for (int k = 0; k < 64; ++k) {
        const float hk = __shfl(h, k); const float* r = wl + k * 1024 + lane;
#pragma unroll
        for (int i = 0; i < 16; ++i) o[i] += hk * r[64 * i];
    }
    const float MIN_D = -3.0701134573253944f, MAX_D = -15.350567286626973f;
#pragma unroll
    for (int i = 0; i < 8; ++i) {
        const int ch = lane + 64 * i;
        const float delta = fabsf(MIN_D + (MAX_D - MIN_D) * ((float)ch / 511.f));
        const float dec = expf(-tl * delta);
        const float hf = o[i] * dec, hb = o[i + 8] * dec;
        if (!isctx) {
            bf16_t* R = (bf16_t*)(c.pp->ws + WS_RL) + ((size_t)l * 512 + ch) * 4096;
            if (pos == 0) { R[2048] = f2bf(hf + hb + bias[ch]); R[0] = 0; } else { R[2048 - pos] = f2bf(hf); R[2048 + pos] = f2bf(hb); }
        } else {
            float* R = (float*)(c.pp->ws + WS_RC) + (size_t)ch * 512;
            if (pos == 0) { R[256] = hf + hb + bias[ch]; R[0] = 0.f; } else { R[256 + pos] = hf; R[256 - pos] = hb; }
        }
    }
}

DI void rope_item(const Ctx& c, int item) {
    const int idx = item * NTHREADS + c.tid, t = idx >> 5, ip = idx & 31;
    const int row = t >> 6, col = t & 63, j = ip & 15;
    const float inv = powf(10000.f, -(float)j / 16.f);
    const float ang = (float)(ip < 16 ? row : col) * inv;
    float* R = (float*)(c.pp->ws + WS_ROPE);
    R[(size_t)idx * 2] = cosf(ang); R[(size_t)idx * 2 + 1] = sinf(ang);
}

constexpr int CV_PER_LAYER = (1984 + 384 + 256 + 1408 + 704) / 8;
DI void phase_prologue(const Ctx& c0) {
    const int N_ADA = 192, N_HYF = 544, N_ROPE = 128, N_CV = 2 * CV_PER_LAYER;
    const int total = N_ADA + N_HYF + N_ROPE + N_CV;
    for (int it = c0.bid; it < total; it += c0.nb) {
        const Ctx c = relaunder(c0);
        if (it < N_ADA) { adaln_item(c, it); continue; }
        int i = it - N_ADA;
        if (i < N_HYF) { hyfilt_item(c, i); continue; }
        i -= N_HYF;
        if (i < N_ROPE) { rope_item(c, i); continue; }
        i -= N_ROPE;
        const int l = i / CV_PER_LAYER; int t = i % CV_PER_LAYER;
        float* lds = (float*)c.lds;
        if (t < 248) { convert_tile4(c.pp->in[10] + (size_t)l * D * DIN, wptr(c, l, OFF_WIN), D, DIN, t, lds, c.tid); continue; }
        t -= 248;
        if (t < 48) { const int br = t / 16; convert_tile4(c.pp->in[24 + br] + (size_t)l * 512 * D, wptr(c, l, OFF_WO + br * SZ_WO1), 512, D, t % 16, lds, c.tid); continue; }
        t -= 48;
        if (t < 32) { convert_tile4(c.pp->in[27] + (size_t)l * D * D, wptr(c, l, OFF_WOUT), D, D, t, lds, c.tid); continue; }
        t -= 32;
        if (t < 176) { convert_tile4(c.pp->in[28] + (size_t)l * D * NUP, wptr(c, l, OFF_WUP), D, NUP, t, lds, c.tid, true); continue; }
        t -= 176;
        convert_tile4(c.pp->in[31] + (size_t)l * DFF * D, wptr(c, l, OFF_WDN), DFF, D, t, lds, c.tid);
    }
}

DI float* resid_ptr(const Ctx& c, int row) { return row < ML ? c.pp->out + (size_t)row * D : (float*)(c.pp->ws + WS_CTXR) + (size_t)(row - ML) * D; }
DI const float* input_ptr(const Ctx& c, int row) { return row < ML ? c.pp->in[0] + (size_t)row * D : c.pp->in[2] + (size_t)(row - ML) * D; }
DI int mod_row_of(int row) { return row < ML ? (row >> 11) : 32; }

constexpr int RPW = 4;
DI void phase_mod0(const Ctx& c) {
    bf16_t* HX = (bf16_t*)(c.pp->ws + WS_HX);
    const float* g = c.pp->in[6];
    const int rpw0 = ((M + c.nb * 8 * RPW - 1) / (c.nb * 8 * RPW)) * RPW;
    for (int rbase = (c.bid * 8 + c.wave) * rpw0; rbase < (c.bid * 8 + c.wave + 1) * rpw0 && rbase < M; rbase += RPW) {
        float4 v[RPW][4]; float ss[RPW];
#pragma unroll
        for (int r = 0; r < RPW; ++r) {
            const float* xr = input_ptr(c, rbase + r);
#pragma unroll
            for (int i = 0; i < 4; ++i) v[r][i] = nt_load4(xr + i * 256 + c.lane * 4);
        }
#pragma unroll
        for (int r = 0; r < RPW; ++r) {
            ss[r] = 0.f;
#pragma unroll
            for (int i = 0; i < 4; ++i) ss[r] += v[r][i].x * v[r][i].x + v[r][i].y * v[r][i].y + v[r][i].z * v[r][i].z + v[r][i].w * v[r][i].w;
        }
#pragma unroll
        for (int o = 32; o > 0; o >>= 1)
#pragma unroll
            for (int r = 0; r < RPW; ++r) ss[r] += __shfl_xor(ss[r], o);
        const float* md = mods_ptr(c, 0, mod_row_of(rbase));
        float rs[RPW];
#pragma unroll
        for (int r = 0; r < RPW; ++r) rs[r] = rsqrtf(ss[r] * (1.f / 1024.f) + EPS);
#pragma unroll
        for (int i = 0; i < 4; ++i) {
            const int cc = i * 256 + c.lane * 4;
            const float4 gg = *(const float4*)(g + cc), sh = *(const float4*)(md + cc), sc = *(const float4*)(md + 1024 + cc);
            const float4 ms = make_float4(gg.x * (1.f + sc.x), gg.y * (1.f + sc.y), gg.z * (1.f + sc.z), gg.w * (1.f + sc.w));
#pragma unroll
            for (int r = 0; r < RPW; ++r) {
                u32x2 o; o.x = pk2(v[r][i].x * rs[r] * ms.x + sh.x, v[r][i].y * rs[r] * ms.y + sh.y);
                o.y = pk2(v[r][i].z * rs[r] * ms.z + sh.z, v[r][i].w * rs[r] * ms.w + sh.w);
                *(u32x2*)(HX + (size_t)(rbase + r) * D + cc) = o;
            }
        }
    }
}

DI void phase_resid(const Ctx& c, int nrows, const bf16_t* Y, const float* gpost, int lg, int gate_idx, bool from_input, bool do_mod, const float* gmod, int lm, int sh_idx) {
    bf16_t* HX = (bf16_t*)(c.pp->ws + WS_HX);
    const int rpw = ((nrows + c.nb * 8 * RPW - 1) / (c.nb * 8 * RPW)) * RPW;
    for (int rbase = (c.bid * 8 + c.wave) * rpw; rbase < (c.bid * 8 + c.wave + 1) * rpw && rbase < nrows; rbase += RPW) {
        u32x2 yu[RPW][4]; float4 xv[RPW][4]; float ss[RPW], s2[RPW];
#pragma unroll
        for (int r = 0; r < RPW; ++r) {
            const int row = rbase + r;
            const float* xr = from_input ? input_ptr(c, row) : (const float*)resid_ptr(c, row);
#pragma unroll
            for (int i = 0; i < 4; ++i) { yu[r][i] = *(const u32x2*)(Y + (size_t)row * D + i * 256 + c.lane * 4); xv[r][i] = nt_load4(xr + i * 256 + c.lane * 4); }
        }
#pragma unroll
        for (int r = 0; r < RPW; ++r) {
            ss[r] = 0.f;
#pragma unroll
            for (int i = 0; i < 4; ++i) { const float a = bf_lo(yu[r][i].x), b = bf_hi(yu[r][i].x), cq = bf_lo(yu[r][i].y), d = bf_hi(yu[r][i].y); ss[r] += a * a + b * b + cq * cq + d * d; }
        }
#pragma unroll
        for (int o = 32; o > 0; o >>= 1)
#pragma unroll
            for (int r = 0; r < RPW; ++r) ss[r] += __shfl_xor(ss[r], o);
        const int mr = mod_row_of(rbase);
        const float* mg = mods_ptr(c, lg, mr) + gate_idx * 1024;
        float rs[RPW];
#pragma unroll
        for (int r = 0; r < RPW; ++r) { rs[r] = rsqrtf(ss[r] * (1.f / 1024.f) + EPS); s2[r] = 0.f; }
#pragma unroll
        for (int i = 0; i < 4; ++i) {
            const int cc = i * 256 + c.lane * 4;
            const float4 gp = *(const float4*)(gpost + cc), gt = *(const float4*)(mg + cc);
            const float4 gg = make_float4(gt.x * gp.x, gt.y * gp.y, gt.z * gp.z, gt.w * gp.w);
#pragma unroll
            for (int r = 0; r < RPW; ++r) {
                float4 o;
                o.x = xv[r][i].x + gg.x * (bf_lo(yu[r][i].x) * rs[r]); o.y = xv[r][i].y + gg.y * (bf_hi(yu[r][i].x) * rs[r]);
                o.z = xv[r][i].z + gg.z * (bf_lo(yu[r][i].y) * rs[r]); o.w = xv[r][i].w + gg.w * (bf_hi(yu[r][i].y) * rs[r]);
                nt_store4(resid_ptr(c, rbase + r) + cc, o);
                xv[r][i] = o;
                s2[r] += o.x * o.x + o.y * o.y + o.z * o.z + o.w * o.w;
            }
        }
        if (do_mod) {
#pragma unroll
            for (int o = 32; o > 0; o >>= 1)
#pragma unroll
                for (int r = 0; r < RPW; ++r) s2[r] += __shfl_xor(s2[r], o);
            const float* md = mods_ptr(c, lm, mr) + sh_idx * 1024;
            float r2[RPW];
#pragma unroll
            for (int r = 0; r < RPW; ++r) r2[r] = rsqrtf(s2[r] * (1.f / 1024.f) + EPS);
#pragma unroll
            for (int i = 0; i < 4; ++i) {
                const int cc = i * 256 + c.lane * 4;
                const float4 gg = *(const float4*)(gmod + cc), sh = *(const float4*)(md + cc), sc = *(const float4*)(md + 1024 + cc);
                const float4 ms = make_float4(gg.x * (1.f + sc.x), gg.y * (1.f + sc.y), gg.z * (1.f + sc.z), gg.w * (1.f + sc.w));
#pragma unroll
                for (int r = 0; r < RPW; ++r) {
                    u32x2 o; o.x = pk2(xv[r][i].x * r2[r] * ms.x + sh.x, xv[r][i].y * r2[r] * ms.y + sh.y);
                    o.y = pk2(xv[r][i].z * r2[r] * ms.z + sh.z, xv[r][i].w * r2[r] * ms.w + sh.w);
                    *(u32x2*)(HX + (size_t)(rbase + r) * D + cc) = o;
                }
            }
        }
    }
}

struct OneUnitOrder {
    pg8::StaticOrder S; int r;
    __device__ bool next(int i, pg8::Unit& u) const { return i == 0 && S.next(r, u); }
    __device__ __forceinline__ void a_ready(const pg8::Unit&) const {}
    __device__ __forceinline__ void done(const pg8::Unit&) const {}
};
template <int MODE>
DI void run_gemm_round(const Ctx& c, int r, const bf16_t* A, const bf16_t* Bt, int Mr, int N, int K, bf16_t* O, int ldc, const bf16_t* G) {
    pg8::Gemm g{A, Bt, Mr, N, K};
    OneUnitOrder S; S.S.init(Mr, N, c.nb, c.bid); S.r = r;
    pg8::EpiT<MODE> E{O, ldc, G};
    pg8::gemm_phase<pg8::EpiT<MODE>, OneUnitOrder, true, true>((LAS unsigned char*)c.lds, g, S, E);
    __syncthreads();
}
template <int MODE>
DI void run_gemm(const Ctx& c, const bf16_t* A, const bf16_t* Bt, int Mr, int N, int K, bf16_t* O, int ldc, const bf16_t* G) {
    pg8::Gemm g{A, Bt, Mr, N, K};
    pg8::StaticOrder S; S.init(Mr, N, c.nb, c.bid);
    pg8::EpiT<MODE> E{O, ldc, G};
    pg8::gemm_phase<pg8::EpiT<MODE>, pg8::StaticOrder, true, true>((LAS unsigned char*)c.lds, g, S, E);
    __syncthreads();
#if (PROBE_MASK & 1)
    if (MODE != 3) { pg8::gemm_phase<pg8::EpiT<MODE>, pg8::StaticOrder, true, true>((LAS unsigned char*)c.lds, g, S, E); __syncthreads(); }
#endif
}

DI void run_gemm_ffn_up(const Ctx& c, int l, int r0, int rows) {
    pg8::Gemm g{(const bf16_t*)(c.pp->ws + WS_HX) + (size_t)r0 * D, wptr(c, l, OFF_WUP), rows, NUP, D};
    pg8::StaticOrder S; S.init(rows, NUP, c.nb, c.bid);
    pg8::EpiFfn E{(bf16_t*)(c.pp->ws + A_ACT), (bf16_t*)(c.pp->ws + A_ZUP), c.pp->in[29] + (size_t)l * 3 * NUP, c.pp->in[30] + l * NUP, (LAS float*)((LAS unsigned char*)c.lds + 131072)};
    pg8::gemm_phase<pg8::EpiFfn, pg8::StaticOrder, true, true>((LAS unsigned char*)c.lds, g, S, E);
    __syncthreads();
}
DI void phase_ffn_fix(const Ctx& c, int l, int r0, int nrows) {
    const bf16_t* EDGE = (const bf16_t*)(c.pp->ws + A_ZUP); bf16_t* ACT = (bf16_t*)(c.pp->ws + A_ACT);
    const float* cw = c.pp->in[29] + (size_t)l * 3 * NUP; const float* cb = c.pp->in[30] + l * NUP;
    const int ncg = DFF / 8, nunits = (nrows / 256) * 2 * ncg;
    for (int u = c.bid * NTHREADS + c.tid; u < nunits; u += c.nb * NTHREADS) {
        const int cgp = u % ncg, te = u / ncg, e = te & 1, tile = te >> 1, col = cgp * 8, tok = e ? 255 : 0;
        const int grow = r0 + tile * 256 + tok, seqmask = (grow < ML) ? (L - 1) : (LC - 1);
        const bool first = (grow & seqmask) == 0, last = (grow & seqmask) == seqmask;
        const bf16_t* rp = e ? EDGE + ((size_t)tile * 4 + 2) * NUP : EDGE + ((size_t)tile * 4 - 1) * NUP;
        u32x4 z[2][3];
#pragma unroll
        for (int pt = 0; pt < 2; ++pt)
#pragma unroll
            for (int i = 0; i < 3; ++i) {
                const bool ok = !((i == 0 && first) || (i == 2 && last));
                z[pt][i] = (u32x4){0u, 0u, 0u, 0u};
                if (ok) z[pt][i] = *(const u32x4*)(rp + (size_t)i * NUP + pt * DFF + col);
            }
        float ua[8], ub[8];
#pragma unroll
        for (int j = 0; j < 8; ++j) {
            float va[3], vb[3];
#pragma unroll
            for (int i = 0; i < 3; ++i) { va[i] = (j & 1) ? bf_hi(z[0][i][j >> 1]) : bf_lo(z[0][i][j >> 1]); vb[i] = (j & 1) ? bf_hi(z[1][i][j >> 1]) : bf_lo(z[1][i][j >> 1]); }
            ua[j] = va[0] * cw[col + j] + va[1] * cw[NUP + col + j] + va[2] * cw[2 * NUP + col + j] + cb[col + j];
            ub[j] = vb[0] * cw[DFF + col + j] + vb[1] * cw[NUP + DFF + col + j] + vb[2] * cw[2 * NUP + DFF + col + j] + cb[DFF + col + j];
        }
        u32x4 o;
        o.x = pk2(siluf_(ua[0]) * ub[0], siluf_(ua[1]) * ub[1]); o.y = pk2(siluf_(ua[2]) * ub[2], siluf_(ua[3]) * ub[3]);
        o.z = pk2(siluf_(ua[4]) * ub[4], siluf_(ua[5]) * ub[5]); o.w = pk2(siluf_(ua[6]) * ub[6], siluf_(ua[7]) * ub[7]);
        *(u32x4*)(ACT + (size_t)(tile * 256 + tok) * DFF + col) = o;
    }
}

DI void ffn_fix_tile(const Ctx& c, int l, int tile) {
    const bf16_t* EDGE = (const bf16_t*)(c.pp->ws + A_ZUP); bf16_t* ACT = (bf16_t*)(c.pp->ws + A_ACT);
    const float* cw = c.pp->in[29] + (size_t)l * 3 * NUP; const float* cb = c.pp->in[30] + l * NUP;
    const int ncg = DFF / 8;
    for (int u = c.tid; u < 2 * ncg; u += NTHREADS) {
        const int cgp = u % ncg, e = u / ncg, col = cgp * 8, tok = e ? 255 : 0;
        const int grow = tile * 256 + tok, seqmask = (grow < ML) ? (L - 1) : (LC - 1);
        const bool first = (grow & seqmask) == 0, last = (grow & seqmask) == seqmask;
        const bf16_t* rp = e ? EDGE + ((size_t)tile * 4 + 2) * NUP : EDGE + ((size_t)tile * 4 - 1) * NUP;
        u32x4 z[2][3];
#pragma unroll
        for (int pt = 0; pt < 2; ++pt)
#pragma unroll
            for (int i = 0; i < 3; ++i) {
                const bool ok = !((i == 0 && first) || (i == 2 && last));
                z[pt][i] = (u32x4){0u, 0u, 0u, 0u};
                if (ok) z[pt][i] = *(const u32x4*)(rp + (size_t)i * NUP + pt * DFF + col);
            }
        float ua[8], ub[8];
#pragma unroll
        for (int j = 0; j < 8; ++j) {
            float va[3], vb[3];
#pragma unroll
            for (int i = 0; i < 3; ++i) { va[i] = (j & 1) ? bf_hi(z[0][i][j >> 1]) : bf_lo(z[0][i][j >> 1]); vb[i] = (j & 1) ? bf_hi(z[1][i][j >> 1]) : bf_lo(z[1][i][j >> 1]); }
            ua[j] = va[0] * cw[col + j] + va[1] * cw[NUP + col + j] + va[2] * cw[2 * NUP + col + j] + cb[col + j];
            ub[j] = vb[0] * cw[DFF + col + j] + vb[1] * cw[NUP + DFF + col + j] + vb[2] * cw[2 * NUP + DFF + col + j] + cb[DFF + col + j];
        }
        u32x4 o;
        o.x = pk2(siluf_(ua[0]) * ub[0], siluf_(ua[1]) * ub[1]); o.y = pk2(siluf_(ua[2]) * ub[2], siluf_(ua[3]) * ub[3]);
        o.z = pk2(siluf_(ua[4]) * ub[4], siluf_(ua[5]) * ub[5]); o.w = pk2(siluf_(ua[6]) * ub[6], siluf_(ua[7]) * ub[7]);
        *(u32x4*)(ACT + (size_t)(tile * 256 + tok) * DFF + col) = o;
    }
}
DI void run_gemm_ffn_down(const Ctx& c, int l, int nrows) {
    pg8::StaticOrder S; S.init(nrows, D, c.nb, c.bid);
    pg8::Unit u;
#pragma unroll 1
    for (int i = 0; S.next(i, u); ++i) { const Ctx cl = relaunder(c); ffn_fix_tile(cl, l, u.pm); }
    asm volatile("s_waitcnt vmcnt(0)" ::: "memory");
    __syncthreads();
    run_gemm<0>(c, (const bf16_t*)(c.pp->ws + A_ACT), wptr(c, l, OFF_WDN), nrows, D, DFF, (bf16_t*)(c.pp->ws + WS_HX), D, nullptr);
}

DI void attn_prep_item(const Ctx& c, int l, int item) {
    const bf16_t* Z = (const bf16_t*)(c.pp->ws + P_R1);
    bf16_t* Q = (bf16_t*)(c.pp->ws + P_RQ); bf16_t* Kb = (bf16_t*)(c.pp->ws + P_RK); bf16_t* VT = (bf16_t*)(c.pp->ws + P_RV);
    const float* rope = (const float*)(c.pp->ws + WS_ROPE);
    const float* qn = c.pp->in[13] + l * 64; const float* kn = c.pp->in[14] + l * 64;
    bf16_t* vt_l = (bf16_t*)c.lds;
    const int row0 = item * 64, lane = c.lane;
    int b, p0; bool latent;
    if (row0 < ML) { b = row0 >> 11; p0 = 256 + (row0 & 2047); latent = true; } else { const int rc = row0 - ML; b = rc >> 8; p0 = rc & 255; latent = false; }
    u32x4 qraw[8]; unsigned kraw[8], vraw[8];
#pragma unroll
    for (int tk = 0; tk < 8; ++tk) {
        const bf16_t* zr = Z + (size_t)(row0 + c.wave * 8 + tk) * 2304;
        qraw[tk] = *(const u32x4*)(zr + (lane >> 3) * 64 + (lane & 7) * 8);
        kraw[tk] = *(const unsigned*)(zr + 512 + (lane >> 5) * 64 + (lane & 31) * 2);
        vraw[tk] = *(const unsigned*)(zr + 640 + (lane >> 5) * 64 + (lane & 31) * 2);
    }
#pragma unroll
    for (int tk = 0; tk < 8; ++tk) {
        const int ti = c.wave * 8 + tk, p = p0 + ti, t = p - 256;
        {
            const int hq = lane >> 3, d0 = (lane & 7) * 8;
            const u32x4 u = qraw[tk];
            float x[8] = {bf_lo(u.x), bf_hi(u.x), bf_lo(u.y), bf_hi(u.y), bf_lo(u.z), bf_hi(u.z), bf_lo(u.w), bf_hi(u.w)};
            float ss = 0.f;
#pragma unroll
            for (int j = 0; j < 8; ++j) ss += x[j] * x[j];
            ss += __shfl_xor(ss, 1); ss += __shfl_xor(ss, 2); ss += __shfl_xor(ss, 4);
            const float rs = rsqrtf(ss * (1.f / 64.f) + EPS);
#pragma unroll
            for (int j = 0; j < 8; ++j) x[j] = x[j] * rs * qn[d0 + j];
            if (latent) {
#pragma unroll
                for (int j = 0; j < 4; ++j) {
                    const int ip = (d0 >> 1) + j; const float2 cs = *(const float2*)(rope + ((size_t)t * 32 + ip) * 2);
                    const float x1 = x[2 * j], x2 = x[2 * j + 1];
                    x[2 * j] = x1 * cs.x - x2 * cs.y; x[2 * j + 1] = x1 * cs.y + x2 * cs.x;
                }
            }
            const float sc = 0.125f * 1.4426950408889634f;
            u32x4 o; o.x = pk2(x[0] * sc, x[1] * sc); o.y = pk2(x[2] * sc, x[3] * sc); o.z = pk2(x[4] * sc, x[5] * sc); o.w = pk2(x[6] * sc, x[7] * sc);
            *(u32x4*)(Q + (((size_t)(b * 8 + hq) * LT + p) * 64 + d0)) = o;
        }
        {
            const int kvh = lane >> 5, d0 = (lane & 31) * 2;
            const unsigned u = kraw[tk];
            float x1 = bf_lo(u), x2 = bf_hi(u);
            float ss = x1 * x1 + x2 * x2;
            ss += __shfl_xor(ss, 1); ss += __shfl_xor(ss, 2); ss += __shfl_xor(ss, 4); ss += __shfl_xor(ss, 8); ss += __shfl_xor(ss, 16);
            const float rs = rsqrtf(ss * (1.f / 64.f) + EPS);
            x1 = x1 * rs * kn[d0]; x2 = x2 * rs * kn[d0 + 1];
            if (latent) { const float2 cs = *(const float2*)(rope + ((size_t)t * 32 + (lane & 31)) * 2); const float a = x1 * cs.x - x2 * cs.y, bb = x1 * cs.y + x2 * cs.x; x1 = a; x2 = bb; }
            *(unsigned*)(Kb + (((size_t)(b * 2 + kvh) * LT + p) * 64 + d0)) = pk2(x1, x2);
            const unsigned uv = vraw[tk];
            vt_l[(kvh * 64 + d0) * 72 + ti] = (bf16_t)(uv & 0xffffu); vt_l[(kvh * 64 + d0 + 1) * 72 + ti] = (bf16_t)(uv >> 16);
        }
    }
    __syncthreads();
    {
        const int dd = c.tid >> 2, piece = c.tid & 3;
        const u32x4 a = *(const u32x4*)(vt_l + dd * 72 + piece * 16), bq = *(const u32x4*)(vt_l + dd * 72 + piece * 16 + 8);
        bf16_t* dst = VT + ((size_t)(b * 128 + dd) * LT + p0 + piece * 16);
        *(u32x4*)dst = a; *(u32x4*)(dst + 8) = bq;
    }
    __syncthreads();
}

DI void hy_prep_item(const Ctx& c, int l, int item) {
    const bf16_t* Z = (const bf16_t*)(c.pp->ws + P_R1);
    bf16_t* UF = (bf16_t*)(c.pp->ws + P_RU); bf16_t* X0C = (bf16_t*)(c.pp->ws + P_RX);
    const float* cw = c.pp->in[15] + (size_t)l * 3 * 1536; const float* cb = c.pp->in[16] + l * 1536;
    bf16_t* uf_l = (bf16_t*)c.lds;
    const int sg = item >> 3, cgp = item & 7, lane = c.lane;
    const int ch = cgp * 64 + (lane & 31) * 2, t0 = sg * 8;
    float w[3][3][2], bs[3][2];
#pragma unroll
    for (int pt = 0; pt < 3; ++pt) {
#pragma unroll
        for (int tp = 0; tp < 3; ++tp) { w[pt][tp][0] = cw[tp * 1536 + pt * 512 + ch]; w[pt][tp][1] = cw[tp * 1536 + pt * 512 + ch + 1]; }
        bs[pt][0] = cb[pt * 512 + ch]; bs[pt][1] = cb[pt * 512 + ch + 1];
    }
#pragma unroll
    for (int bi = 0; bi < 2; ++bi) {
        const int b = 2 * c.wave + (lane >> 5) + 16 * bi;
        const bf16_t* zb = Z + (size_t)(b * L) * 2304 + 768 + ch;
        unsigned zr[10][3];
#pragma unroll
        for (int i = 0; i < 10; ++i) {
            const int t = t0 - 1 + i; const bool ok = (t >= 0) && (t < L);
#pragma unroll
            for (int pt = 0; pt < 3; ++pt) { zr[i][pt] = 0u; if (ok) zr[i][pt] = *(const unsigned*)(zb + (size_t)t * 2304 + pt * 512); }
        }
#pragma unroll
        for (int s = 0; s < 8; ++s) {
            const int t = t0 + s;
            float zc[3][2];
#pragma unroll
            for (int pt = 0; pt < 3; ++pt) {
                zc[pt][0] = bf_lo(zr[s][pt]) * w[pt][0][0] + bf_lo(zr[s + 1][pt]) * w[pt][1][0] + bf_lo(zr[s + 2][pt]) * w[pt][2][0] + bs[pt][0];
                zc[pt][1] = bf_hi(zr[s][pt]) * w[pt][0][1] + bf_hi(zr[s + 1][pt]) * w[pt][1][1] + bf_hi(zr[s + 2][pt]) * w[pt][2][1] + bs[pt][1];
            }
            *(unsigned*)(X0C + (size_t)(b * L + t) * 512 + ch) = pk2(zc[0][0], zc[0][1]);
            const int cl = (lane & 31) * 2;
            uf_l[((cl) * 32 + b) * 8 + s] = f2bf(zc[2][0] * zc[1][0]);
            uf_l[((cl + 1) * 32 + b) * 8 + s] = f2bf(zc[2][1] * zc[1][1]);
        }
    }
    __syncthreads();
    const int J = sg >> 1, g = sg & 1;
#pragma unroll
    for (int i = 0; i < 4; ++i) {
        const int q = c.tid + NTHREADS * i, cl = q >> 5, b = q & 31;
        const u32x4 v = *(const u32x4*)(uf_l + (cl * 32 + b) * 8);
        *(u32x4*)(UF + ((((size_t)(cgp * 64 + cl) * 128 + J) * 64 + g * 32 + b) * 8)) = v;
    }
    __syncthreads();
}

DI void hy_ctx_item(const Ctx& c, int l, int item) {
    const bf16_t* Z = (const bf16_t*)(c.pp->ws + P_R1);
    bf16_t* CH = (bf16_t*)(c.pp->ws + WS_CH);
    const float* RC = (const float*)(c.pp->ws + WS_RC);
    const float* cw = c.pp->in[15] + (size_t)l * 3 * 1536; const float* cb = c.pp->in[16] + l * 1536;
    float* u_l = (float*)c.lds; float* x0_l = u_l + 256 * 64;
    const int b = item >> 3, cgp = item & 7;
    for (int i = c.tid; i < 256 * 64; i += NTHREADS) {
        const int t = i >> 6, cl = i & 63, ch = cgp * 64 + cl;
        const bf16_t* zb = Z + (size_t)(ML + b * LC) * 2304 + 768 + ch;
        float zc[3];
#pragma unroll
        for (int pt = 0; pt < 3; ++pt) {
            const float a0 = t > 0 ? bf2f(zb[(size_t)(t - 1) * 2304 + pt * 512]) : 0.f, a1 = bf2f(zb[(size_t)t * 2304 + pt * 512]), a2 = t + 1 < LC ? bf2f(zb[(size_t)(t + 1) * 2304 + pt * 512]) : 0.f;
            zc[pt] = a0 * cw[pt * 512 + ch] + a1 * cw[1536 + pt * 512 + ch] + a2 * cw[3072 + pt * 512 + ch] + cb[pt * 512 + ch];
        }
        u_l[t * 64 + cl] = zc[2] * zc[1]; x0_l[t * 64 + cl] = zc[0];
    }
    __syncthreads();
    const int cl = c.tid & 63, t0 = (c.tid >> 6) * 32, ch = cgp * 64 + cl;
    const float* gc = RC + (size_t)ch * 512;
    float acc[32];
#pragma unroll
    for (int i = 0; i < 32; ++i) acc[i] = 0.f;
    for (int s0 = 0; s0 < 256; s0 += 32) {
        float wv[63];
        const int base = t0 - s0 + 256;
#pragma unroll
        for (int k = 0; k < 63; ++k) wv[k] = gc[base - 31 + k];
#pragma unroll
        for (int j = 0; j < 32; ++j) {
            const float uu = u_l[(s0 + j) * 64 + cl];
#pragma unroll
            for (int i = 0; i < 32; ++i) acc[i] += wv[31 + i - j] * uu;
        }
    }
#pragma unroll
    for (int i = 0; i < 32; ++i) CH[(size_t)(b * LC + t0 + i) * 512 + ch] = f2bf(acc[i] * x0_l[(t0 + i) * 64 + cl]);
    __syncthreads();
}

DI void phase_prep(const Ctx& c0, int l) {
    const int n_attn = M / 64, n_hy = 2048, n_ctx = (l == 0) ? 256 : 0;
    const int total = n_ctx + n_attn + n_hy;
    for (int it = c0.bid; it < total; it += c0.nb) {
        const Ctx c = relaunder(c0);
        if (it < n_ctx) hy_ctx_item(c, l, it);
        else if (it < n_ctx + n_attn) attn_prep_item(c, l, it - n_ctx);
        else hy_prep_item(c, l, it - n_ctx - n_attn);
    }
}

DI void attn_item(const Ctx& c, int b, int kvh, int qb) {
    const bf16_t* Q = (const bf16_t*)(c.pp->ws + P_RQ); const bf16_t* Kb = (const bf16_t*)(c.pp->ws + P_RK); const bf16_t* VT = (const bf16_t*)(c.pp->ws + P_RV);
    bf16_t* Bo = (bf16_t*)(c.pp->ws + P_RB);
    constexpr int AT_K = 0, AT_V = 128 * 144, AT_BUF = 128 * 144 + 64 * 264;
    LAS unsigned char* lbase = (LAS unsigned char*)c.lds;
    const int lane = c.lane, r32 = lane & 31, h = lane >> 5, hq = kvh * 4 + (c.wave & 3), qs = c.wave >> 2;
    const int p0 = qb * 64, qrow = p0 + qs * 32 + r32, ntile = (qb < 4) ? 2 : 18;
    bf16x8 qf[4];
    { const bf16_t* qp = Q + (((size_t)(b * 8 + hq) * LT + qrow) * 64) + 8 * h;
#pragma unroll
      for (int s = 0; s < 4; ++s) qf[s] = *(const bf16x8*)(qp + 16 * s); }
    const bf16_t* kg = Kb + (size_t)(b * 2 + kvh) * LT * 64 + c.tid * 8;
    const bf16_t* vg = VT + ((size_t)(b * 2 + kvh) * 64 + (c.tid >> 3)) * LT + (c.tid & 7) * 8;
    const int kst = (c.tid >> 3) * 144 + (c.tid & 7) * 16, vst = (c.tid >> 3) * 264 + (c.tid & 7) * 16;
    u32x4 kreg0 = *(const u32x4*)kg, kreg1 = *(const u32x4*)(kg + 4096), vreg0 = *(const u32x4*)vg, vreg1 = *(const u32x4*)(vg + 64);
    f32x16 o0, o1, o2, negm;
#pragma unroll
    for (int i = 0; i < 16; ++i) { o0[i] = 0.f; o1[i] = 0.f; o2[i] = 0.f; negm[i] = 0.f; }
    const bf16x8 ones = __builtin_bit_cast(bf16x8, (u32x4){0x3F803F80u, 0x3F803F80u, 0x3F803F80u, 0x3F803F80u});
    const float THR = 6.f;
    lds_barrier();
    *(LAS u32x4*)(lbase + AT_K + kst) = kreg0; *(LAS u32x4*)(lbase + AT_K + 64 * 144 + kst) = kreg1;
    *(LAS u32x2*)(lbase + AT_V + vst) = (u32x2){vreg0.x, vreg0.y}; *(LAS u32x2*)(lbase + AT_V + vst + 8) = (u32x2){vreg0.z, vreg0.w}; *(LAS u32x2*)(lbase + AT_V + vst + 128) = (u32x2){vreg1.x, vreg1.y}; *(LAS u32x2*)(lbase + AT_V + vst + 128 + 8) = (u32x2){vreg1.z, vreg1.w};
    if (ntile > 1) { kreg0 = *(const u32x4*)(kg + 8192); kreg1 = *(const u32x4*)(kg + 8192 + 4096); vreg0 = *(const u32x4*)(vg + 128); vreg1 = *(const u32x4*)(vg + 128 + 64); }
    lds_barrier();
    const bool late = c.wave >= 4;
    int slot = 0;
    for (int tile = 0; tile < ntile; ++tile) {
        LAS unsigned char* cur = lbase + slot * AT_BUF;
        slot = (slot == 2) ? 0 : slot + 1;
        if (tile + 1 < ntile) {
            LAS unsigned char* nxt = lbase + slot * AT_BUF;
            *(LAS u32x4*)(nxt + AT_K + kst) = kreg0; *(LAS u32x4*)(nxt + AT_K + 64 * 144 + kst) = kreg1;
            *(LAS u32x2*)(nxt + AT_V + vst) = (u32x2){vreg0.x, vreg0.y}; *(LAS u32x2*)(nxt + AT_V + vst + 8) = (u32x2){vreg0.z, vreg0.w}; *(LAS u32x2*)(nxt + AT_V + vst + 128) = (u32x2){vreg1.x, vreg1.y}; *(LAS u32x2*)(nxt + AT_V + vst + 128 + 8) = (u32x2){vreg1.z, vreg1.w};
            if (tile + 2 < ntile) {
                const bf16_t* k2 = kg + (size_t)(tile + 2) * 8192; const bf16_t* v2 = vg + (tile + 2) * 128;
                kreg0 = *(const u32x4*)k2; kreg1 = *(const u32x4*)(k2 + 4096); vreg0 = *(const u32x4*)v2; vreg1 = *(const u32x4*)(v2 + 64);
            }
        }
        bf16x8 kf[16];
#pragma unroll
        for (int s = 0; s < 4; ++s)
#pragma unroll
            for (int q4 = 0; q4 < 4; ++q4) kf[4 * s + q4] = *(const LAS bf16x8*)(cur + AT_K + (32 * q4 + r32) * 144 + (16 * s + 8 * h) * 2);
        __builtin_amdgcn_sched_barrier(0);
        f32x16 sa0 = negm, sa1 = negm, sb0 = negm, sb1 = negm;
#pragma unroll
        for (int s = 0; s < 4; ++s) {
            sa0 = __builtin_amdgcn_mfma_f32_32x32x16_bf16(kf[4 * s + 0], qf[s], sa0, 0, 0, 0);
            sa1 = __builtin_amdgcn_mfma_f32_32x32x16_bf16(kf[4 * s + 1], qf[s], sa1, 0, 0, 0);
        }
#pragma unroll
        for (int s = 0; s < 4; ++s) {
            sb0 = __builtin_amdgcn_mfma_f32_32x32x16_bf16(kf[4 * s + 2], qf[s], sb0, 0, 0, 0);
            sb1 = __builtin_amdgcn_mfma_f32_32x32x16_bf16(kf[4 * s + 3], qf[s], sb1, 0, 0, 0);
        }
        __builtin_amdgcn_sched_barrier(0);
#pragma unroll
        for (int hf = 0; hf < 2; ++hf) {
            const LAS unsigned char* vt = cur + AT_V + hf * 128;
            u32x2 vfr[4][4];
#pragma unroll
            for (int f = 0; f < 4; ++f) {
                const int koff = (16 * f + 4 * h) * 2;
                vfr[f][0] = *(const LAS u32x2*)(vt + r32 * 264 + koff); vfr[f][1] = *(const LAS u32x2*)(vt + r32 * 264 + koff + 16);
                vfr[f][2] = *(const LAS u32x2*)(vt + (32 + r32) * 264 + koff); vfr[f][3] = *(const LAS u32x2*)(vt + (32 + r32) * 264 + koff + 16);
            }
            __builtin_amdgcn_sched_barrier(0);
            f32x16& s0 = hf ? sb0 : sa0; f32x16& s1 = hf ? sb1 : sa1;
            float mt = fmaxf(fmaxf(s0[0], s0[1]), s0[2]);
#pragma unroll
            for (int i = 3; i < 15; i += 2) mt = fmaxf(fmaxf(mt, s0[i]), s0[i + 1]);
            mt = fmaxf(fmaxf(mt, s0[15]), s1[0]);
#pragma unroll
            for (int i = 1; i < 15; i += 2) mt = fmaxf(fmaxf(mt, s1[i]), s1[i + 1]);
            mt = fmaxf(mt, s1[15]);
            mt = fmaxf(mt, __shfl_xor(mt, 32));
            if (__builtin_amdgcn_ballot_w64(mt > THR) != 0ull) {
                const float delta = mt > THR ? mt : 0.f, alpha = __builtin_amdgcn_exp2f(-delta);
#pragma unroll
                for (int i = 0; i < 16; ++i) { negm[i] -= delta; s0[i] -= delta; s1[i] -= delta; o0[i] *= alpha; o1[i] *= alpha; o2[i] *= alpha; }
                if (hf == 0) {
#pragma unroll
                    for (int i = 0; i < 16; ++i) { sb0[i] -= delta; sb1[i] -= delta; }
                }
            }
#pragma unroll
            for (int i = 0; i < 16; ++i) { s0[i] = __builtin_amdgcn_exp2f(s0[i]); s1[i] = __builtin_amdgcn_exp2f(s1[i]); }
            bf16x8 pf[4];
#pragma unroll
            for (int s2 = 0; s2 < 2; ++s2) {
                pf[s2] = __builtin_bit_cast(bf16x8, (u32x4){pk2(s0[8 * s2], s0[8 * s2 + 1]), pk2(s0[8 * s2 + 2], s0[8 * s2 + 3]), pk2(s0[8 * s2 + 4], s0[8 * s2 + 5]), pk2(s0[8 * s2 + 6], s0[8 * s2 + 7])});
                pf[2 + s2] = __builtin_bit_cast(bf16x8, (u32x4){pk2(s1[8 * s2], s1[8 * s2 + 1]), pk2(s1[8 * s2 + 2], s1[8 * s2 + 3]), pk2(s1[8 * s2 + 4], s1[8 * s2 + 5]), pk2(s1[8 * s2 + 6], s1[8 * s2 + 7])});
            }
            __builtin_amdgcn_sched_barrier(0);
            if (hf == 1 && late) lds_barrier();
#pragma unroll
            for (int f = 0; f < 4; ++f) {
                const bf16x8 va = __builtin_bit_cast(bf16x8, (u32x4){vfr[f][0].x, vfr[f][0].y, vfr[f][1].x, vfr[f][1].y});
                const bf16x8 vb = __builtin_bit_cast(bf16x8, (u32x4){vfr[f][2].x, vfr[f][2].y, vfr[f][3].x, vfr[f][3].y});
                o0 = __builtin_amdgcn_mfma_f32_32x32x16_bf16(va, pf[f], o0, 0, 0, 0);
                o1 = __builtin_amdgcn_mfma_f32_32x32x16_bf16(vb, pf[f], o1, 0, 0, 0);
                o2 = __builtin_amdgcn_mfma_f32_32x32x16_bf16(ones, pf[f], o2, 0, 0, 0);
            }
            __builtin_amdgcn_sched_barrier(0);
        }
        if (!late) lds_barrier();
    }
    const float inv = 1.f / o2[0];
    const int orow = (qrow < 256) ? (ML + b * LC + qrow) : (b * L + qrow - 256);
    bf16_t* op = Bo + (size_t)orow * 512 + hq * 64;
#pragma unroll
    for (int g4 = 0; g4 < 4; ++g4) {
        u32x2 w0, w1;
        w0.x = pk2(o0[4 * g4] * inv, o0[4 * g4 + 1] * inv); w0.y = pk2(o0[4 * g4 + 2] * inv, o0[4 * g4 + 3] * inv);
        w1.x = pk2(o1[4 * g4] * inv, o1[4 * g4 + 1] * inv); w1.y = pk2(o1[4 * g4 + 2] * inv, o1[4 * g4 + 3] * inv);
        *(u32x2*)(op + 8 * g4 + 4 * h) = w0; *(u32x2*)(op + 32 + 8 * g4 + 4 * h) = w1;
    }
}

constexpr int HY_CS = 8224;
DI void hy_conv_item(const Ctx& c, int l, int ch) {
    const bf16_t* R = (const bf16_t*)(c.pp->ws + WS_RL) + ((size_t)l * 512 + ch) * 4096;
    const bf16_t* UF = (const bf16_t*)(c.pp->ws + P_RU) + (size_t)ch * 128 * 512;
    bf16_t* YT = (bf16_t*)(c.pp->ws + P_RY) + (size_t)ch * 2048 * 32;
    __syncthreads();
    for (int i = c.tid; i < 8 * 4096; i += NTHREADS) {
        const int r = i >> 12, m = i & 4095, src = m + r;
        *(LAS bf16_t*)((LAS unsigned char*)c.lds + r * HY_CS + m * 2) = (src < 4096) ? R[src] : (bf16_t)0;
    }
    __syncthreads();
    const int lane = c.lane, ir = lane & 31, g = lane >> 5;
    const int nb0 = 2048 - ir + 8 * g;
    const int rr = nb0 & 7, qq = nb0 >> 3;
    const LAS unsigned char* abase = (const LAS unsigned char*)c.lds + rr * HY_CS + qq * 16;
    f32x16 acc[8];
#pragma unroll
    for (int i = 0; i < 8; ++i)
#pragma unroll
        for (int j = 0; j < 16; ++j) acc[i][j] = 0.f;
    const int I0 = c.wave * 8;
    bf16x8 a0[8], a1[8];
#pragma unroll
    for (int i = 0; i < 8; ++i) { a0[i] = *(const LAS bf16x8*)(abase + (0 - 4 * (I0 + i)) * 16); a1[i] = *(const LAS bf16x8*)(abase + (2 - 4 * (I0 + i)) * 16); }
    bf16x8 bcur = *(const bf16x8*)(UF + (size_t)lane * 8);
    for (int jb = 0; jb < 64; jb += 8) {
#pragma unroll
        for (int jj = 0; jj < 8; ++jj) {
#pragma unroll
            for (int p = 0; p < 2; ++p) {
                const int J = 2 * (jb + jj) + p;
                const int Jn = (J + 1 < 128) ? J + 1 : J, J2 = (J + 2 < 128) ? J + 2 : J;
                const bf16x8 bnext = *(const bf16x8*)(UF + ((size_t)Jn * 64 + lane) * 8);
                const bf16x8 fnew = *(const LAS bf16x8*)(abase + (2 * J2 - 4 * I0) * 16);
#pragma unroll
                for (int i = 0; i < 8; ++i) acc[i] = __builtin_amdgcn_mfma_f32_32x32x16_bf16(p ? a1[(i - jj) & 7] : a0[(i - jj) & 7], bcur, acc[i], 0, 0, 0);
                if (p) a1[(7 - jj) & 7] = fnew; else a0[(7 - jj) & 7] = fnew;
                bcur = bnext;
            }
        }
    }
    int irl = ir; asm volatile("" : "+v"(irl));
    bf16_t* yb = YT + (size_t)(I0 * 32 + 4 * g) * 32 + irl;
#pragma unroll
    for (int i = 0; i < 8; ++i)
#pragma unroll
        for (int rg = 0; rg < 16; ++rg) yb[(i * 32 + (rg & 3) + 8 * (rg >> 2)) * 32] = f2bf(acc[i][rg]);
}

DI void hy_final_item(const Ctx& c, int item) {
    const bf16_t* YT = (const bf16_t*)(c.pp->ws + P_RY); const bf16_t* X0C = (const bf16_t*)(c.pp->ws + P_RX);
    bf16_t* Co = (bf16_t*)(c.pp->ws + P_RQ);
    bf16_t* y_l = (bf16_t*)c.lds;
    const int sg = item >> 3, cgp = item & 7, t0 = sg * 8;
#pragma unroll
    for (int i = 0; i < 4; ++i) {
        const int q = c.tid + NTHREADS * i, cl = q >> 5, piece = q & 31;
        const u32x4 v = *(const u32x4*)(YT + ((size_t)(cgp * 64 + cl) * 2048 + t0) * 32 + piece * 8);
        *(u32x4*)(y_l + cl * 264 + piece * 8) = v;
    }
    __syncthreads();
#pragma unroll
    for (int k = 0; k < 16; ++k) {
        const int idx = c.tid + NTHREADS * k, chp = idx & 31, bt = idx >> 5, t = bt & 7, b = bt >> 3;
        const float y0 = bf2f(y_l[(2 * chp) * 264 + t * 32 + b]), y1 = bf2f(y_l[(2 * chp + 1) * 264 + t * 32 + b]);
        const size_t off = (size_t)(b * L + t0 + t) * 512 + cgp * 64 + 2 * chp;
        const unsigned xv = *(const unsigned*)(X0C + off);
        *(unsigned*)(Co + off) = pk2(y0 * bf_lo(xv), y1 * bf_hi(xv));
    }
    __syncthreads();
}

DI void phase_hyfinal(const Ctx& c, int l) {
    for (int it = c.bid; it < 2048; it += c.nb) hy_final_item(c, it);
    if (l == 0) {
        const u32x4* src = (const u32x4*)(c.pp->ws + WS_CH); u32x4* dst = (u32x4*)((bf16_t*)(c.pp->ws + P_RQ) + (size_t)ML * 512);
        for (int i = c.bid * NTHREADS + c.tid; i < MC * 512 / 8; i += c.nb * NTHREADS) dst[i] = src[i];
    }
}

DI int scan_row(int b, int dir, int n) {
    if (n < LC) return ML + b * LC + (dir ? (LC - 1 - n) : n);
    const int t = n - LC; return b * L + (dir ? (L - 1 - t) : t);
}
constexpr int SC_QD = 0, SC_KG = 8704, SC_KDT = 17408, SC_VT = 25600, SC_EG = 33792, SC_AM = 34304, SC_SET = 36864;
DI void scan_item_mfma(const Ctx& c, int l, int item) {
    const bf16_t* Z = (const bf16_t*)(c.pp->ws + P_R1);
    const int b = item >> 3, hh = (item >> 1) & 3, dir = item & 1;
    bf16_t* Oo = (bf16_t*)(c.pp->ws + (dir ? A_OB : A_OF));
    LAS unsigned char* lds = (LAS unsigned char*)c.lds;
    const int tid = c.tid, lane = c.lane, w = c.wave, r16 = lane & 15, g = lane >> 4;
    const int kp = tid >> 3, tq = tid & 7;
    float lb[2] = {0.f, 0.f};
    if (l == 1) {
#pragma unroll
        for (int e = 0; e < 2; ++e) { const int k = hh * 128 + 2 * kp + e; const float x0 = c.pp->in[11][(0 * 2 + dir) * 512 + k], x1 = c.pp->in[11][(1 * 2 + dir) * 512 + k]; lb[e] = 1.f / (1.f + expf(x0 - x1)); }
    }
    __syncthreads();
    if (tid < 256) { const int set = tid >> 7, q = tid & 127, row = q >> 3, dw = q & 7; *(LAS unsigned*)(lds + set * SC_SET + SC_AM + row * 64 + 32 + dw * 4) = 0u; }
    f32x4 S[8]; u32x2 Sb[8];
#pragma unroll
    for (int i = 0; i < 8; ++i) { S[i] = (f32x4){0.f, 0.f, 0.f, 0.f}; Sb[i] = (u32x2){0u, 0u}; }
    unsigned raw[12];
    const size_t colq = (size_t)hh * 128 + 2 * kp;
    const int rstep = dir ? -1 : 1;
    {
        const bf16_t* base = Z + (size_t)scan_row(b, dir, 4 * tq) * 2560 + colq;
#pragma unroll
        for (int j = 0; j < 4; ++j) {
            const bf16_t* bj = base + (ptrdiff_t)(j * rstep) * 2560;
            raw[3 * j] = *(const unsigned*)bj; raw[3 * j + 1] = *(const unsigned*)(bj + 512 + dir * 512); raw[3 * j + 2] = *(const unsigned*)(bj + 1536);
        }
    }
    const float L2E = 1.4426950408889634f;
    for (int n = 0; n < LT / 32; ++n) {
        LAS unsigned char* ls = lds + (n & 1) * SC_SET;
        {
            float lf[4][2], kk[4][2];
#pragma unroll
            for (int j = 0; j < 4; ++j)
#pragma unroll
                for (int e = 0; e < 2; ++e) {
                    const float z = e ? bf_hi(raw[3 * j + 1]) : bf_lo(raw[3 * j + 1]);
                    const float sg = __builtin_amdgcn_rcpf(1.f + __builtin_amdgcn_exp2f(-z * L2E));
                    const float f = lb[e] + (1.f - lb[e]) * sg;
                    lf[j][e] = __builtin_amdgcn_logf(f); kk[j][e] = 1.f - f;
                }
            float cs[4][2], incl[2], excl[2], glast[2];
#pragma unroll
            for (int e = 0; e < 2; ++e) {
                cs[0][e] = lf[0][e]; cs[1][e] = cs[0][e] + lf[1][e]; cs[2][e] = cs[1][e] + lf[2][e]; cs[3][e] = cs[2][e] + lf[3][e];
                float x = cs[3][e];
#pragma unroll
                for (int d = 1; d < 8; d <<= 1) { const float y = __shfl_up(x, d, 8); if (tq >= d) x += y; }
                incl[e] = x; excl[e] = x - cs[3][e]; glast[e] = __shfl(x, 7, 8);
            }
            float egl[2] = {__builtin_amdgcn_exp2f(glast[0]), __builtin_amdgcn_exp2f(glast[1])};
            float kd[4][2];
#pragma unroll
            for (int j = 0; j < 4; ++j) {
                const int t = 4 * tq + j;
                float qd[2], kg[2];
#pragma unroll
                for (int e = 0; e < 2; ++e) {
                    const float G = excl[e] + cs[j][e];
                    const float q = e ? bf_hi(raw[3 * j]) : bf_lo(raw[3 * j]);
                    qd[e] = q * __builtin_amdgcn_exp2f(G);
                    kg[e] = kk[j][e] * __builtin_amdgcn_exp2f(fminf(-G, 115.f));
                    kd[j][e] = kg[e] * egl[e];
                }
                *(LAS unsigned*)(ls + SC_QD + t * 272 + kp * 4) = pk2(qd[0], qd[1]);
                *(LAS unsigned*)(ls + SC_KG + t * 272 + kp * 4) = pk2(kg[0], kg[1]);
            }
#pragma unroll
            for (int e = 0; e < 2; ++e) {
                u32x2 kw; kw.x = pk2(kd[0][e], kd[1][e]); kw.y = pk2(kd[2][e], kd[3][e]);
                *(LAS u32x2*)(ls + SC_KDT + (2 * kp + e) * 64 + tq * 8) = kw;
                u32x2 vw;
                if (e == 0) { vw.x = (raw[2] & 0xffffu) | (raw[5] << 16); vw.y = (raw[8] & 0xffffu) | (raw[11] << 16); }
                else { vw.x = (raw[2] >> 16) | (raw[5] & 0xffff0000u); vw.y = (raw[8] >> 16) | (raw[11] & 0xffff0000u); }
                *(LAS u32x2*)(ls + SC_VT + (2 * kp + e) * 64 + tq * 8) = vw;
            }
            if (tq == 7) *(LAS f32x2*)(ls + SC_EG + kp * 8) = (f32x2){egl[0], egl[1]};
        }
        lds_barrier();
        if (n + 1 < LT / 32) {
            const bf16_t* base = Z + (size_t)scan_row(b, dir, (n + 1) * 32 + 4 * tq) * 2560 + colq;
#pragma unroll
            for (int j = 0; j < 4; ++j) {
                const bf16_t* bj = base + (ptrdiff_t)(j * rstep) * 2560;
                raw[3 * j] = *(const unsigned*)bj; raw[3 * j + 1] = *(const unsigned*)(bj + 512 + dir * 512); raw[3 * j + 2] = *(const unsigned*)(bj + 1536);
            }
        }
        if (w < 3) {
            const int tt = (w + 1) >> 1, st = (w == 2) ? 1 : 0;
            f32x4 a = {0.f, 0.f, 0.f, 0.f};
#pragma unroll
            for (int ks = 0; ks < 4; ++ks) {
                const bf16x8 qa = *(const LAS bf16x8*)(ls + SC_QD + (16 * tt + r16) * 272 + (32 * ks + 8 * g) * 2);
                const bf16x8 kb = *(const LAS bf16x8*)(ls + SC_KG + (16 * st + r16) * 272 + (32 * ks + 8 * g) * 2);
                a = __builtin_amdgcn_mfma_f32_16x16x32_bf16(qa, kb, a, 0, 0, 0);
            }
#pragma unroll
            for (int r = 0; r < 4; ++r) {
                const int tg = 16 * tt + 4 * g + r, sg = 16 * st + r16;
                *(LAS bf16_t*)(ls + SC_AM + tg * 64 + sg * 2) = f2bf(sg <= tg ? a[r] : 0.f);
            }
        }
        f32x4 o[2] = {(f32x4){0.f, 0.f, 0.f, 0.f}, (f32x4){0.f, 0.f, 0.f, 0.f}};
        {
            u32x2 qa0[4][2], qa1[4][2];
#pragma unroll
            for (int ks = 0; ks < 4; ++ks)
#pragma unroll
                for (int tt = 0; tt < 2; ++tt) {
                    qa0[ks][tt] = *(const LAS u32x2*)(ls + SC_QD + (16 * tt + r16) * 272 + (32 * ks + 4 * g) * 2);
                    qa1[ks][tt] = *(const LAS u32x2*)(ls + SC_QD + (16 * tt + r16) * 272 + (32 * ks + 16 + 4 * g) * 2);
                }
            __builtin_amdgcn_sched_barrier(0);
#pragma unroll
            for (int ks = 0; ks < 4; ++ks) {
                const bf16x8 sb = __builtin_bit_cast(bf16x8, (u32x4){Sb[2 * ks].x, Sb[2 * ks].y, Sb[2 * ks + 1].x, Sb[2 * ks + 1].y});
#pragma unroll
                for (int tt = 0; tt < 2; ++tt) {
                    const bf16x8 qa = __builtin_bit_cast(bf16x8, (u32x4){qa0[ks][tt].x, qa0[ks][tt].y, qa1[ks][tt].x, qa1[ks][tt].y});
                    o[tt] = __builtin_amdgcn_mfma_f32_16x16x32_bf16(qa, sb, o[tt], 0, 0, 0);
                }
            }
        }
        lds_barrier();
        const bf16x8 vb = *(const LAS bf16x8*)(ls + SC_VT + (16 * w + r16) * 64 + g * 16);
#pragma unroll
        for (int tt = 0; tt < 2; ++tt) {
            const bf16x8 am = *(const LAS bf16x8*)(ls + SC_AM + (16 * tt + r16) * 64 + g * 16);
            o[tt] = __builtin_amdgcn_mfma_f32_16x16x32_bf16(am, vb, o[tt], 0, 0, 0);
        }
        {
            bf16_t* ob = Oo + (size_t)scan_row(b, dir, n * 32 + 4 * g) * 512 + hh * 128 + 16 * w + r16;
#pragma unroll
            for (int tt = 0; tt < 2; ++tt)
#pragma unroll
                for (int r = 0; r < 4; ++r) ob[(ptrdiff_t)((16 * tt + r) * rstep) * 512] = f2bf(o[tt][r]);
        }
        {
            f32x4 dec[8]; bf16x8 ka[8];
#pragma unroll
            for (int kt = 0; kt < 8; ++kt) { dec[kt] = *(const LAS f32x4*)(ls + SC_EG + (16 * kt + 4 * g) * 4); ka[kt] = *(const LAS bf16x8*)(ls + SC_KDT + (16 * kt + r16) * 64 + g * 16); }
            __builtin_amdgcn_sched_barrier(0);
#pragma unroll
            for (int kt = 0; kt < 8; ++kt) S[kt] = __builtin_amdgcn_mfma_f32_16x16x32_bf16(ka[kt], vb, S[kt] * dec[kt], 0, 0, 0);
#pragma unroll
            for (int kt = 0; kt < 8; ++kt) { Sb[kt].x = pk2(S[kt][0], S[kt][1]); Sb[kt].y = pk2(S[kt][2], S[kt][3]); }
        }
    }
    __syncthreads();
}

DI void phase_combine(const Ctx& c, int l, int nrows) {
    const bf16_t* Z = (const bf16_t*)(c.pp->ws + P_R1);
    bf16_t* OF = (bf16_t*)(c.pp->ws + A_OF); const bf16_t* OB = (const bf16_t*)(c.pp->ws + A_OB);
    const float* gn = c.pp->in[12] + l * 128;
    const int d0 = (c.lane & 15) * 8;
    float gnv[8];
#pragma unroll
    for (int j = 0; j < 8; ++j) gnv[j] = gn[d0 + j];
    const int rpw = ((nrows + c.nb * 8 * RPW - 1) / (c.nb * 8 * RPW)) * RPW;
    for (int rbase = (c.bid * 8 + c.wave) * rpw; rbase < (c.bid * 8 + c.wave + 1) * rpw && rbase < nrows; rbase += RPW) {
        u32x4 uf[RPW], ub[RPW], ug[RPW];
#pragma unroll
        for (int r = 0; r < RPW; ++r) {
            const size_t off = (size_t)(rbase + r) * 512 + c.lane * 8;
            uf[r] = *(const u32x4*)(OF + off); ub[r] = *(const u32x4*)(OB + off); ug[r] = *(const u32x4*)(Z + (size_t)(rbase + r) * 2560 + 2048 + c.lane * 8);
        }
#pragma unroll
        for (int r = 0; r < RPW; ++r) {
            float s[8], gt[8];
#pragma unroll
            for (int q = 0; q < 4; ++q) { s[2 * q] = bf_lo(uf[r][q]) + bf_lo(ub[r][q]); s[2 * q + 1] = bf_hi(uf[r][q]) + bf_hi(ub[r][q]); gt[2 * q] = bf_lo(ug[r][q]); gt[2 * q + 1] = bf_hi(ug[r][q]); }
            float ss = 0.f;
#pragma unroll
            for (int j = 0; j < 8; ++j) ss += s[j] * s[j];
            ss += __shfl_xor(ss, 1); ss += __shfl_xor(ss, 2); ss += __shfl_xor(ss, 4); ss += __shfl_xor(ss, 8);
            const float rs = rsqrtf(ss * (1.f / 128.f) + EPS);
#pragma unroll
            for (int j = 0; j < 8; ++j) s[j] = s[j] * rs * gnv[j] * siluf_(gt[j]);
            u32x4 o; o.x = pk2(s[0], s[1]); o.y = pk2(s[2], s[3]); o.z = pk2(s[4], s[5]); o.w = pk2(s[6], s[7]);
            *(u32x4*)(OF + (size_t)(rbase + r) * 512 + c.lane * 8) = o;
        }
    }
}

constexpr int NPL = 12;
constexpr int NPHASES = 2 + 2 * NPL;

DI void run_phase(const Ctx& c0, int ph) {
    Ctx c = c0;
    asm volatile("" : "+v"(c.tid)); asm volatile("" : "+s"(c.bid));
    { auto kp = __builtin_amdgcn_kernarg_segment_ptr(); asm volatile("" : "+s"(kp)); c.pp = (ParamsPtr)kp; }
    c.lane = c.tid & 63; c.wave = __builtin_amdgcn_readfirstlane(c.tid >> 6);
    unsigned char* ws = c.pp->ws;
    bf16_t* HX = (bf16_t*)(ws + WS_HX);
    if (ph == 0) { for (int rep = 0; rep < ((PROBE_MASK & 32) ? 2 : 1); ++rep) phase_prologue(c); return; }
    if (ph == 1) { for (int rep = 0; rep < ((PROBE_MASK & 64) ? 2 : 1); ++rep) phase_mod0(c); return; }
    const int l = (ph - 2) / NPL, q = (ph - 2) % NPL;
    const int nrows = (l == 0) ? M : ML;
    switch (q) {
    case 0:
        if (l == 0) run_gemm<0>(c, HX, wptr(c, l, OFF_WIN) + (size_t)2560 * D, M, 2304, D, (bf16_t*)(ws + P_R1), 2304, nullptr);
        else {
            run_gemm<0>(c, HX, wptr(c, l, OFF_WIN) + (size_t)2560 * D, ML, 2304, D, (bf16_t*)(ws + P_R1), 2304, nullptr);
            run_gemm<0>(c, HX + (size_t)ML * D, wptr(c, l, OFF_WIN) + (size_t)(2560 + 512) * D, MC, 256, D, (bf16_t*)(ws + P_R1) + (size_t)ML * 2304 + 512, 2304, nullptr);
        }
        break;
    case 1: for (int rep = 0; rep < ((PROBE_MASK & 16) ? 2 : 1); ++rep) phase_prep(c, l); break;
    case 2: {
        if (l == 0) run_gemm<0>(c, HX, wptr(c, l, OFF_WIN), M, 2560, D, (bf16_t*)(ws + P_R1), 2560, nullptr);
        else {
            run_gemm<0>(c, HX, wptr(c, l, OFF_WIN), ML, 2560, D, (bf16_t*)(ws + P_R1), 2560, nullptr);
            run_gemm<0>(c, HX + (size_t)ML * D, wptr(c, l, OFF_WIN) + (size_t)512 * D, MC, 1536, D, (bf16_t*)(ws + P_R1) + (size_t)ML * 2560 + 512, 2560, nullptr);
        }
        {
            const int nqb = (l == 0) ? 36 : 32, nitems = NB * 2 * nqb;
            const bool loc = (c.nb == 256);
            const int nr = loc ? ((l == 0) ? 9 : 8) : (nitems + c.nb - 1) / c.nb;
#pragma unroll 1
            for (int r = 0; r < nr; ++r) {
                const Ctx cl = relaunder(c);
                int bb, kv, qb;
                if (loc) {
                    if (r < 8) { const int pair = (c.bid & 7) * 8 + r; bb = pair >> 1; kv = pair & 1; qb = 4 + (c.bid >> 3); }
                    else { bb = c.bid >> 3; kv = (c.bid >> 2) & 1; qb = c.bid & 3; }
                } else {
                    const int it = c.bid + r * c.nb; if (it >= nitems) break;
                    const int qi = it / 64, bk = it % 64; bb = bk >> 1; kv = bk & 1; qb = 35 - qi;
                }
                attn_item(cl, bb, kv, qb);
            }
        }
        __syncthreads();
        for (int rep = 0; rep < ((PROBE_MASK & 8) ? 2 : 1); ++rep)
        for (int ch = c.bid; ch < 512; ch += c.nb) hy_conv_item(c, l, ch);
        __syncthreads();
        break; }
    case 3: for (int rep = 0; rep < ((PROBE_MASK & 16) ? 2 : 1); ++rep) phase_hyfinal(c, l); break;
    case 4: for (int rep = 0; rep < ((PROBE_MASK & 2) ? 2 : 1); ++rep) for (int it = c.bid; it < 256; it += c.nb) scan_item_mfma(c, l, it); break;
    case 5: phase_combine(c, l, nrows); break;
    case 6: {
        bf16_t* GB = (bf16_t*)(ws + A_GBUF); bf16_t* MB = (bf16_t*)(ws + A_MBUF);
        const bf16_t* br_in[3] = {(const bf16_t*)(ws + A_OF), (const bf16_t*)(ws + P_RB), (const bf16_t*)(ws + P_RQ)};
        const int nrounds = ((nrows / 256) * 4 + c.nb - 1) / c.nb;
        for (int r = 0; r < nrounds; ++r) {
            run_gemm_round<1>(c, r, HX, wptr(c, l, OFF_WIN) + (size_t)4864 * D, nrows, D, D, GB, D, nullptr);
            run_gemm_round<2>(c, r, br_in[0], wptr(c, l, OFF_WO), nrows, D, 512, MB, D, GB);
            run_gemm_round<1>(c, r, HX, wptr(c, l, OFF_WIN) + (size_t)5888 * D, nrows, D, D, GB, D, nullptr);
            run_gemm_round<3>(c, r, br_in[1], wptr(c, l, OFF_WO + SZ_WO1), nrows, D, 512, MB, D, GB);
            run_gemm_round<1>(c, r, HX, wptr(c, l, OFF_WIN) + (size_t)6912 * D, nrows, D, D, GB, D, nullptr);
            run_gemm_round<3>(c, r, br_in[2], wptr(c, l, OFF_WO + 2 * SZ_WO1), nrows, D, 512, MB, D, GB);
        }
        break; }
    case 7: run_gemm<0>(c, (const bf16_t*)(ws + A_MBUF), wptr(c, l, OFF_WOUT), nrows, D, D, (bf16_t*)(ws + A_GBUF), D, nullptr); break;
    case 8:
        phase_resid(c, nrows, (const bf16_t*)(ws + A_GBUF), c.pp->in[7] + l * D, l, 2, l == 0, true, c.pp->in[8] + l * D, l, 3);
        break;
    case 9: run_gemm_ffn_up(c, l, 0, nrows); break;
    case 10: run_gemm_ffn_down(c, l, nrows); break;
    case 11:
        phase_resid(c, nrows, HX, c.pp->in[9] + l * D, l, 5, false, l == 0, c.pp->in[6] + D, 1, 0);
        break;
    default: break;
    }
}

__global__ void __launch_bounds__(NTHREADS, 2) fwd_megakernel(Params p, int ph_lo, int ph_hi) {
    extern __shared__ __attribute__((aligned(16))) unsigned char smem[];
    Ctx c; c.pp = (ParamsPtr)__builtin_amdgcn_kernarg_segment_ptr(); c.bid = blockIdx.x; c.nb = gridDim.x; c.tid = threadIdx.x; c.wave = __builtin_amdgcn_readfirstlane(threadIdx.x >> 6); c.lane = threadIdx.x & 63; c.lds = smem;
    volatile LAS unsigned* st = (volatile LAS unsigned*)((LAS unsigned char*)smem + LDS_ST_OFF);
    if (threadIdx.x < 4) st[threadIdx.x] = 0u;
    __syncthreads();
    unsigned* bar = (unsigned*)(((ParamsPtr)__builtin_amdgcn_kernarg_segment_ptr())->ws + WS_CTL);
    const XcdBarrier xb = xcd_barrier_post(bar, st);
    for (int ph = ph_lo; ph < ph_hi; ++ph) {
        run_phase(c, ph);
        if (ph + 1 < ph_hi) {
            if (ph == ph_lo) cg::this_grid().sync();
            else xcd_barrier(xb);
        }
    }
}

#ifndef MK_MULTI_LAUNCH
#define MK_MULTI_LAUNCH 0
#endif

extern "C" void kernel_launch(void* const* d_in, const int* in_sizes, int n_in, void* d_out, int out_size, void* d_ws, size_t ws_size, hipStream_t stream) {
    static int grid = 0;
    if (grid == 0) {
        if (n_in != 32 || ws_size < WS_END) { fprintf(stderr, "kernel_launch: need 32 inputs and >= %zu bytes of workspace (got %d, %zu)\n", (size_t)WS_END, n_in, ws_size); grid = -1; return; }
        if (hipFuncSetAttribute((const void*)fwd_megakernel, hipFuncAttributeMaxDynamicSharedMemorySize, LDS_BYTES) != hipSuccess) { fprintf(stderr, "kernel_launch: hipFuncSetAttribute failed\n"); grid = -1; return; }
        int dev = 0, cus = 0, per_cu = 0;
        hipGetDevice(&dev); hipDeviceGetAttribute(&cus, hipDeviceAttributeMultiprocessorCount, dev);
        hipOccupancyMaxActiveBlocksPerMultiprocessor(&per_cu, (const void*)fwd_megakernel, NTHREADS, LDS_BYTES);
        if (per_cu < 1) { fprintf(stderr, "kernel_launch: occupancy query returned %d\n", per_cu); per_cu = 1; }
        (void)hipGetLastError();
        grid = cus * per_cu;
    }
    if (grid < 0) return;
    if (hipMemsetAsync((char*)d_ws + WS_CTL, 0, CTL_BYTES, stream) != hipSuccess) { fprintf(stderr, "kernel_launch: memset of the barrier words failed\n"); return; }
    Params p{};
    for (int i = 0; i < 32; ++i) p.in[i] = (const float*)d_in[i];
    p.out = (float*)d_out; p.ws = (unsigned char*)d_ws;
#if MK_MULTI_LAUNCH
    for (int ph = 0; ph < NPHASES; ++ph) hipLaunchKernelGGL(fwd_megakernel, dim3(grid), dim3(NTHREADS), LDS_BYTES, stream, p, ph, ph + 1);
#else
    int lo = 0, hi = NPHASES;
    void* args[] = {&p, &lo, &hi};
    hipError_t e = hipLaunchCooperativeKernel((const void*)fwd_megakernel, dim3(grid), dim3(NTHREADS), args, LDS_BYTES, stream);
    if (e != hipSuccess) fprintf(stderr, "cooperative launch failed: %s (grid %d)\n", hipGetErrorString(e), grid);
#endif
}
```
